# Optimizing an MI355X kernel written in HIP

```python
import math
import jax, jax.numpy as jnp
from jax import lax
import numpy as np

D_MODEL = 1024
BATCH = 4
SEQ = 4096
DEPTH = 2

GRID_W = 64
HEAD_DIM = 64
ROPE_THETA = 10000.0
EPS = 1e-6
Q_BLOCK = 128
A_HEADS = 6
A_KV_HEADS = 2
A_GROUP = A_HEADS // A_KV_HEADS
B_HEADS = 4
B_Q_RANK = 256
B_KV_RANK = 128
B_NOPE_DIM = 64
B_ROPE_DIM = 32
B_V_DIM = 64
C_HEADS = 6
C_BRANCHES = ((128, 1), (512, 4), (2048, 16))
D_FF = 4 * D_MODEL
N_MOD = 6

IN_SIZES = (A_HEADS * HEAD_DIM, A_KV_HEADS * HEAD_DIM, A_KV_HEADS * HEAD_DIM,
            B_Q_RANK, B_KV_RANK, B_ROPE_DIM,
            C_HEADS * HEAD_DIM, C_HEADS * HEAD_DIM, C_HEADS * HEAD_DIM)
IN_COLS = sum(IN_SIZES)
SPLIT_POINTS = tuple(int(v) for v in np.cumsum(IN_SIZES)[:-1])
A_OUT = A_HEADS * HEAD_DIM
B_OUT = B_HEADS * B_V_DIM
C_OUT = C_HEADS * HEAD_DIM
MIX_WIDTH = A_OUT + B_OUT + C_OUT

kernel_name = "hybrid_gqa_mla_dilated_adaln_encoder"


def rmsnorm(x, g):
    xf = x.astype(jnp.float32)
    y = xf * lax.rsqrt(jnp.mean(xf * xf, axis=-1, keepdims=True) + EPS)
    return (y * g.astype(jnp.float32)).astype(x.dtype)


def rope_angles(pos, dim):
    inv = ROPE_THETA ** (-jnp.arange(0, dim, 2, dtype=jnp.float32) / dim)
    return pos.astype(jnp.float32)[:, None] * inv[None, :]


def apply_rope(x, ang):
    xf = x.astype(jnp.float32)
    x1, x2 = jnp.split(xf, 2, axis=-1)
    cos, sin = jnp.cos(ang), jnp.sin(ang)
    return jnp.concatenate([x1 * cos - x2 * sin, x1 * sin + x2 * cos], axis=-1).astype(x.dtype)


def blocked_attention(q, k, v, scale):
    B, Hk, G, S, Dq = q.shape
    nblk = S // Q_BLOCK
    qb = jnp.moveaxis(q.reshape(B, Hk, G, nblk, Q_BLOCK, Dq), 3, 0)
    kf = k.astype(jnp.float32)

    def one_block(qi):
        s = jnp.einsum('bhgqd,bhkd->bhgqk', qi.astype(jnp.float32), kf) * scale
        p = jax.nn.softmax(s, axis=-1)
        return jnp.einsum('bhgqk,bhkd->bhgqd', p.astype(v.dtype), v)

    ob = lax.map(one_block, qb)
    return jnp.moveaxis(ob, 0, 3).reshape(B, Hk, G, S, v.shape[-1])


def dilated_branch(q, k, v, window, dilation):
    B, H, S, Dh = q.shape
    radius = window // (2 * dilation)
    L = S // dilation

    def strided(a):
        return a.reshape(B, H, L, dilation, Dh).transpose(0, 1, 3, 2, 4)

    qs, ks, vs = strided(q), strided(k), strided(v)
    qb = math.gcd(L, Q_BLOCK)
    nblk = L // qb
    span = qb + 2 * radius
    pad = ((0, 0), (0, 0), (0, 0), (radius, radius), (0, 0))
    kp, vp = jnp.pad(ks, pad), jnp.pad(vs, pad)
    slab_idx = jnp.arange(nblk)[:, None] * qb + jnp.arange(span)[None, :]
    kblk = kp[:, :, :, slab_idx]
    vblk = vp[:, :, :, slab_idx]
    qblk = qs.reshape(B, H, dilation, nblk, qb, Dh)
    s = jnp.einsum('bhrnqd,bhrnkd->bhrnqk', qblk.astype(jnp.float32),
                   kblk.astype(jnp.float32)) * (Dh ** -0.5)
    i_loc = jnp.arange(qb)[:, None]
    j_loc = jnp.arange(span)[None, :]
    band = (j_loc >= i_loc) & (j_loc <= i_loc + 2 * radius)
    valid = (slab_idx >= radius) & (slab_idx < radius + L)
    mask = band[None, :, :] & valid[:, None, :]
    s = jnp.where(mask, s, -jnp.inf)
    lse = jax.nn.logsumexp(s, axis=-1)
    p = jnp.exp(s - lse[..., None])
    o = jnp.einsum('bhrnqk,bhrnkd->bhrnqd', p.astype(v.dtype), vblk)
    o = o.reshape(B, H, dilation, L, Dh).transpose(0, 1, 3, 2, 4).reshape(B, H, S, Dh)
    lse = lse.reshape(B, H, dilation, L).transpose(0, 1, 3, 2).reshape(B, H, S)
    return o, lse


def dilated_mixture(q, k, v):
    outs, lses = [], []
    for window, dilation in C_BRANCHES:
        o, lse = dilated_branch(q, k, v, window, dilation)
        outs.append(o)
        lses.append(lse)
    alpha = jax.nn.softmax(jnp.stack(lses, axis=0), axis=0)
    return jnp.sum(alpha[..., None].astype(v.dtype) * jnp.stack(outs, axis=0), axis=0)


def hybrid_mixer(h, w_in, a_q_norm, a_k_norm, b_q_norm, b_kv_norm, b_w_uq, b_w_ukv,
                 out_gain, ang_axial, ang_mla, ang_dil):
    B, S, _ = h.shape
    proj = h @ w_in
    aq, ak, av, bq, bkv, bkr, cq, ck, cv = jnp.split(proj, SPLIT_POINTS, axis=-1)

    def heads(a, n, d):
        return a.reshape(B, S, n, d).transpose(0, 2, 1, 3)

    def merge(o):
        return o.transpose(0, 2, 1, 3).reshape(B, S, -1)

    qa = apply_rope(rmsnorm(heads(aq, A_HEADS, HEAD_DIM), a_q_norm), ang_axial)
    ka = apply_rope(rmsnorm(heads(ak, A_KV_HEADS, HEAD_DIM), a_k_norm), ang_axial)
    va = heads(av, A_KV_HEADS, HEAD_DIM)
    oa = blocked_attention(qa.reshape(B, A_KV_HEADS, A_GROUP, S, HEAD_DIM), ka, va,
                           HEAD_DIM ** -0.5).reshape(B, A_HEADS, S, HEAD_DIM)

    q_up = heads(rmsnorm(bq, b_q_norm) @ b_w_uq, B_HEADS, B_NOPE_DIM + B_ROPE_DIM)
    q_nope, q_rope = jnp.split(q_up, [B_NOPE_DIM], axis=-1)
    qb_ = jnp.concatenate([q_nope, apply_rope(q_rope, ang_mla)], axis=-1)
    kv_up = heads(rmsnorm(bkv, b_kv_norm) @ b_w_ukv, B_HEADS, B_NOPE_DIM + B_V_DIM)
    k_nope, vb = jnp.split(kv_up, [B_NOPE_DIM], axis=-1)
    k_rope = jnp.broadcast_to(apply_rope(bkr, ang_mla)[:, None], (B, B_HEADS, S, B_ROPE_DIM))
    kb = jnp.concatenate([k_nope, k_rope], axis=-1)
    ob = blocked_attention(qb_[:, :, None], kb, vb, (B_NOPE_DIM + B_ROPE_DIM) ** -0.5)[:, :, 0]

    qc = apply_rope(heads(cq, C_HEADS, HEAD_DIM), ang_dil)
    kc = apply_rope(heads(ck, C_HEADS, HEAD_DIM), ang_dil)
    vc = heads(cv, C_HEADS, HEAD_DIM)
    oc = dilated_mixture(qc, kc, vc)

    g_a, g_b, g_c = jnp.split(out_gain, [A_OUT, A_OUT + B_OUT])
    return jnp.concatenate([rmsnorm(merge(oa), g_a), rmsnorm(merge(ob), g_b),
                            rmsnorm(merge(oc), g_c)], axis=-1)


def setup_inputs(seed: int = 0) -> dict:
    key = jax.random.key(seed)
    ks = jax.random.split(key, 18)

    def nrm(k, shape, s):
        return jax.random.normal(k, shape, jnp.float32) * s

    def gain(k, shape):
        return 1.0 + 0.02 * jax.random.normal(k, shape, jnp.float32)

    return {
        "x": nrm(ks[0], (BATCH, SEQ, D_MODEL), 1.0),
        "c": nrm(ks[1], (BATCH, D_MODEL), 1.0),
        "w_ada": nrm(ks[2], (DEPTH, D_MODEL, N_MOD * D_MODEL), 0.5 * D_MODEL ** -0.5),
        "b_ada": nrm(ks[3], (DEPTH, N_MOD * D_MODEL), 0.02),
        "norm_mix": gain(ks[4], (DEPTH, D_MODEL)),
        "norm_mlp": gain(ks[5], (DEPTH, D_MODEL)),
        "w_in": nrm(ks[6], (DEPTH, D_MODEL, IN_COLS), D_MODEL ** -0.5),
        "a_q_norm": gain(ks[7], (DEPTH, HEAD_DIM)),
        "a_k_norm": gain(ks[8], (DEPTH, HEAD_DIM)),
        "b_q_norm": gain(ks[9], (DEPTH, B_Q_RANK)),
        "b_kv_norm": gain(ks[10], (DEPTH, B_KV_RANK)),
        "b_w_uq": nrm(ks[11], (DEPTH, B_Q_RANK, B_HEADS * (B_NOPE_DIM + B_ROPE_DIM)), B_Q_RANK ** -0.5),
        "b_w_ukv": nrm(ks[12], (DEPTH, B_KV_RANK, B_HEADS * (B_NOPE_DIM + B_V_DIM)), B_KV_RANK ** -0.5),
        "out_gain": gain(ks[13], (DEPTH, MIX_WIDTH)),
        "w_out": nrm(ks[14], (DEPTH, MIX_WIDTH, D_MODEL), MIX_WIDTH ** -0.5),
        "w_ff1": nrm(ks[15], (DEPTH, D_MODEL, D_FF), D_MODEL ** -0.5),
        "w_ff2": nrm(ks[16], (DEPTH, D_FF, D_MODEL), D_FF ** -0.5),
        "final_norm": gain(ks[17], (D_MODEL,)),
    }


def reference(x, c, w_ada, b_ada, norm_mix, norm_mlp, w_in, a_q_norm, a_k_norm, b_q_norm,
              b_kv_norm, b_w_uq, b_w_ukv, out_gain, w_out, w_ff1, w_ff2, final_norm):
    B, S, _ = x.shape
    n_rows = S // GRID_W
    t = jnp.arange(S, dtype=jnp.int32)
    row_idx = jnp.repeat(jnp.arange(n_rows, dtype=jnp.int32), GRID_W)
    col_idx = jnp.tile(jnp.arange(GRID_W, dtype=jnp.int32), n_rows)
    ang_axial = jnp.concatenate([rope_angles(row_idx, HEAD_DIM // 2),
                                 rope_angles(col_idx, HEAD_DIM // 2)], axis=-1)
    ang_mla = rope_angles(t, B_ROPE_DIM)
    ang_dil = rope_angles(t, HEAD_DIM)
    c_act = jax.nn.silu(c)
    for l in range(DEPTH):
        mod = (c_act @ w_ada[l] + b_ada[l])[:, None, :]
        sh1, sc1, g1, sh2, sc2, g2 = jnp.split(mod, N_MOD, axis=-1)
        h = rmsnorm(x, norm_mix[l]) * (1.0 + sc1) + sh1
        y = hybrid_mixer(h, w_in[l], a_q_norm[l], a_k_norm[l], b_q_norm[l], b_kv_norm[l],
                         b_w_uq[l], b_w_ukv[l], out_gain[l], ang_axial, ang_mla, ang_dil)
        x = x + g1 * (y @ w_out[l])
        h = rmsnorm(x, norm_mlp[l]) * (1.0 + sc2) + sh2
        x = x + g2 * (jnp.square(jax.nn.relu(h @ w_ff1[l])) @ w_ff2[l])
    return rmsnorm(x, final_norm)
```

```cpp
#include <hip/hip_runtime.h>
#include <hip/hip_cooperative_groups.h>
#include <cstdio>
#include <cstdint>
namespace cg = cooperative_groups;
namespace pg8 {
#define PG8_LAS __attribute__((address_space(3)))
typedef unsigned short bf16_t;
typedef short bf16x8 __attribute__((ext_vector_type(8)));
typedef float f32x4 __attribute__((ext_vector_type(4)));
typedef unsigned u32x4 __attribute__((ext_vector_type(4)));
constexpr int BM = 256, BK = 64, HALF = 128, HTB = HALF * BK * 2  , STAGE_BYTES = 8 * HTB, NXCD = 8, WGM = 8;

__host__ __device__ __forceinline__ int lds_byte(int r, int c) { const int st = (r >> 4) * 2 + (c >> 5), rr = r & 15, cc = c & 31, ob = rr * 64 + cc * 2; return st * 1024 + (ob ^ (((ob >> 9) & 1) << 5)); }
__host__ __device__ __forceinline__ void stage_rc(int b, int& R, int& C) { const int st = b / 1024, sb = b % 1024, swz = sb ^ (((sb >> 9) & 1) << 5); R = (st >> 1) * 16 + swz / 64; C = (st & 1) * 32 + (swz % 64) / 2; }
__host__ __device__ __forceinline__ int perm32(int rho) { const int n = rho >> 4, i = rho & 15; return 8 * (i >> 2) + 4 * n + (i & 3); }

struct Unit { int pm, pn; };
struct Gemm { const bf16_t* A; const bf16_t* Bt; int M, N, K; };

struct StaticOrder {
    int nM, nN, nwg, G, c;
    __host__ __device__ void init(int M, int N, int G_, int c_) { nM = M / BM; nN = N / BM; nwg = nM * nN; G = G_; c = c_; }
    __host__ __device__ bool next(int i, Unit& u) const {
        const long L = (long)i * G + c; if (L >= nwg) return false;
        int wgid = (int)L; { const int q = nwg / NXCD, r = nwg % NXCD, xcd = wgid % NXCD, off = wgid / NXCD; wgid = (xcd < r ? xcd * (q + 1) : r * (q + 1) + (xcd - r) * q) + off; }
        const int nig = WGM * nN, gid = wgid / nig, fm = gid * WGM, gsz = (nM - fm) < WGM ? (nM - fm) : WGM;
        u.pm = fm + ((wgid % nig) % gsz); u.pn = (wgid % nig) / gsz; return true;
    }
    __device__ __forceinline__ void a_ready(const Unit&) const {}
    __device__ __forceinline__ void done(const Unit&) const {}
};

__device__ __forceinline__ unsigned cvt_pk_bf16(float lo, float hi) { unsigned r; asm volatile("v_cvt_pk_bf16_f32 %0, %1, %2" : "=v"(r) : "v"(lo), "v"(hi)); return r; }
typedef float f32x2 __attribute__((ext_vector_type(2)));

template <int ACT> struct EpiStore {
    static constexpr bool PERM = true, AFTER_DRAIN = false;
    bf16_t* O; int ldc; int nvalid;
    __device__ __forceinline__ void operator()(const f32x4 (&acc)[2][2][4][2], const Unit& u, int wr, int wc, int fr_, int fq_) const {
        int ln = __builtin_amdgcn_mbcnt_hi(~0u, __builtin_amdgcn_mbcnt_lo(~0u, 0u)); asm volatile("" : "+v"(ln)); const int fr = ln & 15, fq = ln >> 4;
        const int row0 = u.pm * BM + wr * 64 + fr; const int col0 = u.pn * BM + wc * 32 + 8 * fq;
#pragma unroll
        for (int ai = 0; ai < 2; ++ai)
#pragma unroll
            for (int m = 0; m < 4; ++m) { bf16_t* rowp = O + (size_t)(row0 + ai * HALF + m * 16) * ldc;
#pragma unroll
                for (int bj = 0; bj < 2; ++bj) { const int c = col0 + bj * HALF;
                    if (c < nvalid) { f32x4 v0 = acc[ai][bj][m][0], v1 = acc[ai][bj][m][1];
                        if (ACT == 2) { v0 = __builtin_elementwise_max(v0, (f32x4){0.f, 0.f, 0.f, 0.f}); v1 = __builtin_elementwise_max(v1, (f32x4){0.f, 0.f, 0.f, 0.f}); v0 = v0 * v0; v1 = v1 * v1; }
                        u32x4 w; w.x = cvt_pk_bf16(v0[0], v0[1]); w.y = cvt_pk_bf16(v0[2], v0[3]); w.z = cvt_pk_bf16(v1[0], v1[1]); w.w = cvt_pk_bf16(v1[2], v1[3]);
                        *(u32x4*)(rowp + c) = w; } } }
    }
};
struct EpiResid {
    static constexpr bool PERM = false, AFTER_DRAIN = false;
    const float* base; float* out; const float* gate;
    __device__ __forceinline__ void operator()(const f32x4 (&acc)[2][2][4][2], const Unit& u, int wr, int wc, int fr_, int fq_) const {
        int ln = __builtin_amdgcn_mbcnt_hi(~0u, __builtin_amdgcn_mbcnt_lo(~0u, 0u)); asm volatile("" : "+v"(ln)); const int fr = ln & 15, fq = ln >> 4;
        const float* g = gate + (size_t)((u.pm * BM) >> 12) * 6144;
        const int col0 = u.pn * BM + wc * 32 + 4 * fq;
#pragma unroll
        for (int bj = 0; bj < 2; ++bj)
#pragma unroll
            for (int n = 0; n < 2; ++n) { const int col = col0 + bj * HALF + n * 16; const f32x4 gv = *(const f32x4*)(g + col);
#pragma unroll
                for (int ai = 0; ai < 2; ++ai)
#pragma unroll
                    for (int m = 0; m < 4; ++m) { const size_t off = (size_t)(u.pm * BM + ai * HALF + wr * 64 + m * 16 + fr) * 1024 + col;
                        const f32x4 b = *(const f32x4*)(base + off); *(f32x4*)(out + off) = b + gv * acc[ai][bj][m][n]; } }
    }
};
typedef unsigned u32x2v __attribute__((ext_vector_type(2)));
struct EpiResidH {
    static constexpr bool PERM = false, AFTER_DRAIN = false;
    const float* base; float* out; const float* gate; const float* nw; const float* sc; bf16_t* H2; float* ssq;
    __device__ __forceinline__ void operator()(const f32x4 (&acc)[2][2][4][2], const Unit& u, int wr, int wc, int fr_, int fq_) const {
        int ln = __builtin_amdgcn_mbcnt_hi(~0u, __builtin_amdgcn_mbcnt_lo(~0u, 0u)); asm volatile("" : "+v"(ln)); const int fr = ln & 15, fq = ln >> 4;
        const size_t boff = (size_t)((u.pm * BM) >> 12) * 6144;
        const float* g = gate + boff; const float* scb = sc + boff;
        const int col0 = u.pn * BM + wc * 32 + 4 * fq;
        f32x4 gv[2][2], cv[2][2];
#pragma unroll
        for (int bj = 0; bj < 2; ++bj)
#pragma unroll
            for (int n = 0; n < 2; ++n) { const int col = col0 + bj * HALF + n * 16; gv[bj][n] = *(const f32x4*)(g + col); cv[bj][n] = *(const f32x4*)(nw + col) * (*(const f32x4*)(scb + col) + 1.0f); }
#pragma unroll
        for (int ai = 0; ai < 2; ++ai)
#pragma unroll
            for (int m = 0; m < 4; ++m) { const int row = u.pm * BM + ai * HALF + wr * 64 + m * 16 + fr; float sq = 0.f;
#pragma unroll
                for (int bj = 0; bj < 2; ++bj)
#pragma unroll
                    for (int n = 0; n < 2; ++n) { const size_t off = (size_t)row * 1024 + col0 + bj * HALF + n * 16;
                        const f32x4 o = *(const f32x4*)(base + off) + gv[bj][n] * acc[ai][bj][m][n]; *(f32x4*)(out + off) = o;
                        sq += (o.x * o.x + o.y * o.y) + (o.z * o.z + o.w * o.w);
                        if (H2) { const f32x4 h = o * cv[bj][n]; u32x2v w; w.x = cvt_pk_bf16(h.x, h.y); w.y = cvt_pk_bf16(h.z, h.w); *(u32x2v*)(H2 + off) = w; } }
                { auto r = __builtin_amdgcn_permlane16_swap(__float_as_uint(sq), __float_as_uint(sq), false, false); sq = __uint_as_float(r[0]) + __uint_as_float(r[1]); }
                { auto r = __builtin_amdgcn_permlane32_swap(__float_as_uint(sq), __float_as_uint(sq), false, false); sq = __uint_as_float(r[0]) + __uint_as_float(r[1]); }
                if (H2 && fq == 0) (void)__hip_atomic_fetch_add(ssq + row, sq, __ATOMIC_RELAXED, __HIP_MEMORY_SCOPE_AGENT); }
    }
};
template <int ACT> struct EpiStoreRS {
    static constexpr bool PERM = true, AFTER_DRAIN = false;
    bf16_t* O; int ldc; const float* ssq; const float* bias; int ldb;
    __device__ __forceinline__ void operator()(const f32x4 (&acc)[2][2][4][2], const Unit& u, int wr, int wc, int fr_, int fq_) const {
        int ln = __builtin_amdgcn_mbcnt_hi(~0u, __builtin_amdgcn_mbcnt_lo(~0u, 0u)); asm volatile("" : "+v"(ln)); const int fr = ln & 15, fq = ln >> 4;
        const int row0 = u.pm * BM + wr * 64 + fr; const int col0 = u.pn * BM + wc * 32 + 8 * fq;
        const float* bb = bias + (size_t)((u.pm * BM) >> 12) * ldb + col0;
        f32x4 bv[2][2];
#pragma unroll
        for (int bj = 0; bj < 2; ++bj) { bv[bj][0] = *(const f32x4*)(bb + bj * HALF); bv[bj][1] = *(const f32x4*)(bb + bj * HALF + 4); }
#pragma unroll
        for (int ai = 0; ai < 2; ++ai)
#pragma unroll
            for (int m = 0; m < 4; ++m) { const int row = row0 + ai * HALF + m * 16; const float rs = 1.0f / sqrtf(ssq[row] * (1.0f / 1024.0f) + 1e-6f);
                bf16_t* rowp = O + (size_t)row * ldc;
#pragma unroll
                for (int bj = 0; bj < 2; ++bj) { f32x4 v0 = acc[ai][bj][m][0] * rs + bv[bj][0], v1 = acc[ai][bj][m][1] * rs + bv[bj][1];
                    if (ACT == 2) { v0 = __builtin_elementwise_max(v0, (f32x4){0.f, 0.f, 0.f, 0.f}); v1 = __builtin_elementwise_max(v1, (f32x4){0.f, 0.f, 0.f, 0.f}); v0 = v0 * v0; v1 = v1 * v1; }
                    u32x4 w; w.x = cvt_pk_bf16(v0[0], v0[1]); w.y = cvt_pk_bf16(v0[2], v0[3]); w.z = cvt_pk_bf16(v1[0], v1[1]); w.w = cvt_pk_bf16(v1[2], v1[3]);
                    *(u32x4*)(rowp + col0 + bj * HALF) = w; } }
    }
};
template <class Epi, class Sched, bool ALIGN_EPI = false, bool SP2 = false>
__device__ __forceinline__ void gemm_phase(PG8_LAS unsigned char* lds, const Gemm g, const Sched& S, const Epi& E) {
    int tid_raw = threadIdx.x; asm volatile("" : "+v"(tid_raw));
    const int tid = tid_raw, wid = __builtin_amdgcn_readfirstlane(tid >> 6), lane = tid & 63, wr = wid >> 2, wc = wid & 3, fr = lane & 15, fq = lane >> 4;
    const int K = g.K, nt = K / BK;
    unsigned voffA[2], voffB[2];
#pragma unroll
    for (int i = 0; i < 2; ++i) { int R, C; stage_rc(tid * 16 + i * 8192, R, C); const int Rb = Epi::PERM ? ((R & ~31) + perm32(R & 31)) : R;
        voffA[i] = (unsigned)(R * K + C) * 2u; voffB[i] = (unsigned)(Rb * K + C) * 2u; }
    const size_t kstep = (size_t)(BK * 2);
    const size_t hstep = (size_t)HALF * K * 2;
    const size_t tstep = 2 * hstep;
    const unsigned ldsw = (unsigned)wid * 1024u;
    const int aoff = lds_byte(wr * 64 + fr, fq * 8), boff = lds_byte(wc * 32 + fr, fq * 8);
#define PG8_SA(b, h) (((b) * 2 + (h)) * HTB)
#define PG8_SB(b, h) ((4 + (b) * 2 + (h)) * HTB)
#define PG8_STAGE(bufoff, gbase, voff) do { _Pragma("unroll") for (int _i = 0; _i < 2; ++_i) \
        __builtin_amdgcn_global_load_lds((const unsigned*)((const char*)(gbase) + (voff)[_i]), (PG8_LAS unsigned*)(lds + (bufoff) + ldsw + _i * 8192), 16, 0, 0); } while (0)
#define PG8_LDA(dst, b, h) do { _Pragma("unroll") for (int m = 0; m < 4; ++m) _Pragma("unroll") for (int k = 0; k < 2; ++k) dst[m][k] = *(const PG8_LAS bf16x8*)(lds + PG8_SA(b, h) + aoff + m * 2048 + k * 1024); } while (0)
#define PG8_LDB(dst, b, h) do { _Pragma("unroll") for (int n = 0; n < 2; ++n) _Pragma("unroll") for (int k = 0; k < 2; ++k) dst[n][k] = *(const PG8_LAS bf16x8*)(lds + PG8_SB(b, h) + boff + n * 2048 + k * 1024); } while (0)
#define PG8_MMA(ai, bj, At, Bt) do { __builtin_amdgcn_s_setprio(1); _Pragma("unroll") for (int m = 0; m < 4; ++m) _Pragma("unroll") for (int n = 0; n < 2; ++n) _Pragma("unroll") for (int k = 0; k < 2; ++k) \
        acc[ai][bj][m][n] = __builtin_amdgcn_mfma_f32_16x16x32_bf16(Bt[n][k], At[m][k], acc[ai][bj][m][n], 0, 0, 0); __builtin_amdgcn_s_setprio(0); } while (0)
#define PG8_WAIT_V(n) asm volatile("s_waitcnt vmcnt(" #n ")" ::: "memory")
#define PG8_WAIT_L(n) asm volatile("s_waitcnt lgkmcnt(" #n ")" ::: "memory")
#define PG8_BAR __builtin_amdgcn_s_barrier()
#define PG8_SCHED __builtin_amdgcn_sched_barrier(0)
    Unit cur, nxt; int ui = 0;
    if (!S.next(0, cur)) return;
    f32x4 acc[2][2][4][2];
#pragma unroll
    for (int a = 0; a < 2; ++a)
#pragma unroll
        for (int b = 0; b < 2; ++b)
#pragma unroll
            for (int m = 0; m < 4; ++m)
#pragma unroll
                for (int n = 0; n < 2; ++n) acc[a][b][m][n] = (f32x4){0.f, 0.f, 0.f, 0.f};
    bf16x8 At[4][2], B0[2][2], B1[2][2];
    const char* cA = (const char*)g.A + (size_t)cur.pm * tstep; const char* cB = (const char*)g.Bt + (size_t)cur.pn * tstep;
    S.a_ready(cur);
    if constexpr (SP2) {
        PG8_STAGE(PG8_SB(0, 0), cB, voffB); PG8_STAGE(PG8_SB(0, 1), cB + hstep, voffB); PG8_STAGE(PG8_SA(0, 0), cA, voffA); PG8_STAGE(PG8_SA(0, 1), cA + hstep, voffA);
        if (wr == 1) PG8_BAR;
        PG8_WAIT_V(2); PG8_BAR;
        PG8_STAGE(PG8_SB(1, 0), cB + kstep, voffB); PG8_STAGE(PG8_SA(1, 0), cA + kstep, voffA); PG8_STAGE(PG8_SB(1, 1), cB + hstep + kstep, voffB);
        PG8_WAIT_V(6); PG8_BAR;
    } else {
        PG8_STAGE(PG8_SB(0, 0), cB, voffB); PG8_STAGE(PG8_SA(0, 0), cA, voffA); PG8_STAGE(PG8_SB(0, 1), cB + hstep, voffB); PG8_STAGE(PG8_SA(0, 1), cA + hstep, voffA);
        if (wr == 1) PG8_BAR;
        PG8_WAIT_V(4); PG8_BAR;
        PG8_STAGE(PG8_SB(1, 0), cB + kstep, voffB); PG8_STAGE(PG8_SA(1, 0), cA + kstep, voffA); PG8_STAGE(PG8_SB(1, 1), cB + hstep + kstep, voffB);
        PG8_WAIT_V(6); PG8_BAR;
    }
    for (;;) {
        const bool has_next = S.next(ui + 1, nxt);
        const char* nA = has_next ? (const char*)g.A + (size_t)nxt.pm * tstep : cA; const char* nB = has_next ? (const char*)g.Bt + (size_t)nxt.pn * tstep : cB;
        for (int t = 0; t < nt; t += 2) {
            const bool last = (t == nt - 2);
            const char* a1 = cA + (size_t)(t + 1) * kstep;
            const char* a2 = last ? nA : cA + (size_t)(t + 2) * kstep; const char* b2 = last ? nB : cB + (size_t)(t + 2) * kstep;
            const char* a3 = a2 + kstep; const char* b3 = b2 + kstep;
            if (last && has_next) S.a_ready(nxt);
            if constexpr (SP2) {
            PG8_LDB(B0, 0, 0); PG8_LDB(B1, 0, 1); PG8_SCHED; PG8_LDA(At, 0, 0); PG8_STAGE(PG8_SA(1, 1), a1 + hstep, voffA);
            PG8_WAIT_V(8); PG8_WAIT_L(0); PG8_BAR; PG8_MMA(0, 0, At, B0); PG8_MMA(0, 1, At, B1); PG8_BAR; PG8_SCHED;
            PG8_LDA(At, 0, 1); PG8_STAGE(PG8_SB(0, 0), b2, voffB); PG8_STAGE(PG8_SB(0, 1), b2 + hstep, voffB); PG8_STAGE(PG8_SA(0, 0), a2, voffA);
            PG8_WAIT_V(8); PG8_WAIT_L(0); PG8_BAR; PG8_MMA(1, 0, At, B0); PG8_MMA(1, 1, At, B1); PG8_BAR; PG8_SCHED;
            PG8_LDB(B0, 1, 0); PG8_LDB(B1, 1, 1); PG8_SCHED; PG8_LDA(At, 1, 0); PG8_STAGE(PG8_SA(0, 1), a2 + hstep, voffA);
            PG8_WAIT_V(8); PG8_WAIT_L(0); PG8_BAR; PG8_MMA(0, 0, At, B0); PG8_MMA(0, 1, At, B1); PG8_BAR; PG8_SCHED;
            PG8_LDA(At, 1, 1); PG8_STAGE(PG8_SB(1, 0), b3, voffB); PG8_STAGE(PG8_SB(1, 1), b3 + hstep, voffB); PG8_STAGE(PG8_SA(1, 0), a3, voffA);
            PG8_WAIT_V(8); PG8_WAIT_L(0); PG8_BAR; PG8_MMA(1, 0, At, B0); PG8_MMA(1, 1, At, B1); PG8_BAR; PG8_SCHED;
            } else {
            PG8_LDB(B0, 0, 0); PG8_SCHED; PG8_LDA(At, 0, 0); PG8_STAGE(PG8_SA(1, 1), a1 + hstep, voffA);
            PG8_WAIT_L(8); PG8_BAR; PG8_WAIT_L(0); PG8_MMA(0, 0, At, B0); PG8_BAR; PG8_SCHED;
            PG8_LDB(B1, 0, 1); PG8_STAGE(PG8_SB(0, 0), b2, voffB);
            PG8_BAR; PG8_WAIT_L(0); PG8_MMA(0, 1, At, B1); PG8_BAR;
            PG8_LDA(At, 0, 1); PG8_STAGE(PG8_SA(0, 0), a2, voffA);
            PG8_BAR; PG8_WAIT_L(0); PG8_MMA(1, 0, At, B0); PG8_BAR; PG8_SCHED;
            PG8_STAGE(PG8_SB(0, 1), b2 + hstep, voffB);
            PG8_WAIT_V(6); PG8_BAR; PG8_MMA(1, 1, At, B1); PG8_BAR;
            PG8_LDB(B0, 1, 0); PG8_SCHED; PG8_LDA(At, 1, 0); PG8_STAGE(PG8_SA(0, 1), a2 + hstep, voffA);
            PG8_WAIT_L(8); PG8_BAR; PG8_WAIT_L(0); PG8_MMA(0, 0, At, B0); PG8_BAR; PG8_SCHED;
            PG8_LDB(B1, 1, 1); PG8_STAGE(PG8_SB(1, 0), b3, voffB);
            PG8_BAR; PG8_WAIT_L(0); PG8_MMA(0, 1, At, B1); PG8_BAR;
            PG8_LDA(At, 1, 1); PG8_STAGE(PG8_SA(1, 0), a3, voffA);
            PG8_BAR; PG8_WAIT_L(0); PG8_MMA(1, 0, At, B0); PG8_BAR; PG8_SCHED;
            PG8_STAGE(PG8_SB(1, 1), b3 + hstep, voffB);
            PG8_WAIT_V(6); PG8_BAR; PG8_MMA(1, 1, At, B1); PG8_BAR;
            }
        }
        if constexpr (ALIGN_EPI) { if (wr == 0) PG8_BAR; }
        if constexpr (!Epi::AFTER_DRAIN) { E(acc, cur, wr, wc, fr, fq); S.done(cur); }
        if (!has_next) break;
#pragma unroll
        for (int a = 0; a < 2; ++a)
#pragma unroll
            for (int b = 0; b < 2; ++b)
#pragma unroll
                for (int m = 0; m < 4; ++m)
#pragma unroll
                    for (int n = 0; n < 2; ++n) acc[a][b][m][n] = (f32x4){0.f, 0.f, 0.f, 0.f};
        cur = nxt; cA = nA; cB = nB; ++ui;
        if constexpr (ALIGN_EPI) { if (wr == 1) PG8_BAR; }
    }
    PG8_WAIT_V(0);
    if constexpr (!ALIGN_EPI) { if (wr == 0) PG8_BAR; }
    PG8_BAR;
    if constexpr (Epi::AFTER_DRAIN) { E.fused(acc, cur, wr, wc, fr, fq, lds, wid, lane); S.done(cur); }
#undef PG8_SA
#undef PG8_SB
#undef PG8_STAGE
#undef PG8_LDA
#undef PG8_LDB
#undef PG8_MMA
#undef PG8_WAIT_V
#undef PG8_WAIT_L
#undef PG8_BAR
#undef PG8_SCHED
}
}

#define DI __device__ __forceinline__
#define LAS __attribute__((address_space(3)))
typedef unsigned short bf16_t;
typedef float f32x4 __attribute__((ext_vector_type(4)));
typedef unsigned u32x4 __attribute__((ext_vector_type(4)));
typedef unsigned u32x2 __attribute__((ext_vector_type(2)));
constexpr int T_TOK = 16384, SEQ = 4096, DM = 1024, NPROJ = 2304, DFF = 4096, NMOD = 6144;
constexpr float EPS = 1e-6f;
constexpr float LOG2E = 1.4426950408889634f;
constexpr float QSCALE64 = 0.125f * LOG2E;
constexpr float QSCALE96 = 0.10206207261596577f * LOG2E;
constexpr int C_AQ = 0, C_AK = 384, C_AV = 512, C_BQ = 640, C_BKV = 896, C_BKR = 1024, C_CQ = 1056, C_CK = 1440, C_CV = 1824;
constexpr size_t MiB = 1u << 20;
constexpr size_t WS_CTL = 0, WS_MOD = 65536;
constexpr size_t WS_CSAX = 1 * MiB, WS_CSDIL = 2 * MiB, WS_CSMLA = 3 * MiB;
constexpr size_t WS_WIN = 4 * MiB, WS_WOUT = 13 * MiB, WS_WFF1 = 17 * MiB, WS_WFF2 = 33 * MiB, WS_WUQ = 49 * MiB, WS_WUKV = 49 * MiB + 512 * 1024;
constexpr size_t WS_H = 50 * MiB, WS_PROJ = 82 * MiB, WS_QB = 154 * MiB, WS_KVB = 166 * MiB, WS_YAB = 182 * MiB, WS_YC = 202 * MiB, WS_LSE = 238 * MiB;
constexpr size_t WS_BQN = 240 * MiB, WS_BKVN = 248 * MiB, WS_HID = 82 * MiB, WS_END = 252 * MiB;
constexpr size_t WS_SSQ = 3 * MiB + 512 * 1024, WS_BIAS2 = WS_SSQ + 131072;
constexpr size_t WS_SSQ1 = WS_BIAS2 + 131072, WS_BIAS1 = WS_SSQ1 + 131072;
constexpr size_t WS_H2 = 210 * MiB;
constexpr int LDS_BYTES = 147456;

__device__ const double INV64[32] = {1.0, 0.7498942093324559, 0.5623413251903491, 0.4216965034285822, 0.31622776601683794, 0.23713737056616552, 0.1778279410038923, 0.1333521432163324, 0.1, 0.07498942093324558, 0.05623413251903491, 0.042169650342858224, 0.03162277660168379, 0.023713737056616554, 0.01778279410038923, 0.01333521432163324, 0.01, 0.007498942093324558, 0.005623413251903491, 0.004216965034285823, 0.0031622776601683794, 0.0023713737056616554, 0.0017782794100389228, 0.001333521432163324, 0.001, 0.0007498942093324559, 0.0005623413251903491, 0.00042169650342858224, 0.00031622776601683794, 0.00023713737056616554, 0.00017782794100389227, 0.0001333521432163324};

DI float bf2f(bf16_t v) { return __uint_as_float((unsigned)v << 16); }
DI unsigned f2bf(float f) { unsigned u = __float_as_uint(f); return (u + 0x7fffu + ((u >> 16) & 1u)) >> 16; }
DI unsigned pk2(float lo, float hi) { return f2bf(lo) | (f2bf(hi) << 16); }
DI float wave_sum(float v) {
#pragma unroll
    for (int o = 1; o < 64; o <<= 1) v += __shfl_xor(v, o);
    return v;
}
DI float2 cs_of(double a) {
    const double rv = a * 0.15915494309189535; const double fr = rv - rint(rv); const float f = (float)fr;
    return make_float2(__builtin_amdgcn_cosf(f), __builtin_amdgcn_sinf(f));
}

struct Params { const float* in[18]; float* out; unsigned char* ws; };
typedef const __attribute__((address_space(4))) Params* KParams;
DI KParams kparams() { KParams k = (KParams)__builtin_amdgcn_kernarg_segment_ptr(); asm volatile("" : "+s"(k)); return k; }
#define PIN(i) (kparams()->in[i])
#define POUT (kparams()->out)
#define PWS (kparams()->ws)

DI void transpose_item(const float* W, int K, int N, bf16_t* WT, LAS float* scr, int item, int lane) {
    const int nblk = N / 32, kb = item / nblk, nb = item % nblk, k0 = 64 * kb, n0 = 32 * nb;
#pragma unroll 8
    for (int i = 0; i < 32; ++i) { const int kk = 2 * i + (lane >> 5); scr[kk * 33 + (lane & 31)] = W[(size_t)(k0 + kk) * N + n0 + (lane & 31)]; }
    asm volatile("s_waitcnt lgkmcnt(0)" ::: "memory");
    const int c = lane & 7;
#pragma unroll
    for (int j = 0; j < 4; ++j) { const int n = (lane >> 3) + 8 * j; const LAS float* s = scr + (8 * c) * 33 + n;
        u32x4 o; o.x = pk2(s[0 * 33], s[1 * 33]); o.y = pk2(s[2 * 33], s[3 * 33]); o.z = pk2(s[4 * 33], s[5 * 33]); o.w = pk2(s[6 * 33], s[7 * 33]);
        *(u32x4*)(WT + (size_t)(n0 + n) * K + k0 + 8 * c) = o; }
    asm volatile("s_waitcnt lgkmcnt(0)" ::: "memory");
}

DI void phase_prologue(unsigned char* lds, int bid, int G, int tid, int lane, int wave) {
    unsigned char* ws = PWS;
    {
        float* sil = (float*)lds;
        float* red = (float*)(lds + 16384);
        for (int i = tid; i < 4096; i += 512) { const float c = PIN(1)[i]; sil[i] = c / (1.f + __expf(-c)); }
        __syncthreads();
        float* mod = (float*)(ws + WS_MOD);
        for (int item = bid; item < 192; item += G) {
            const int l = item / 96, cgp = item % 96, col = cgp * 64 + lane;
            const float* W = PIN(2) + (size_t)l * 1024 * NMOD + col;
            float a0 = 0.f, a1 = 0.f, a2 = 0.f, a3 = 0.f;
            const int k0 = wave * 128;
#pragma unroll 8
            for (int k = k0; k < k0 + 128; ++k) { const float w = W[(size_t)k * NMOD]; a0 += sil[k] * w; a1 += sil[1024 + k] * w; a2 += sil[2048 + k] * w; a3 += sil[3072 + k] * w; }
            red[(wave * 4 + 0) * 64 + lane] = a0; red[(wave * 4 + 1) * 64 + lane] = a1; red[(wave * 4 + 2) * 64 + lane] = a2; red[(wave * 4 + 3) * 64 + lane] = a3;
            __syncthreads();
            if (wave < 4) { float s = 0.f;
#pragma unroll
                for (int w8 = 0; w8 < 8; ++w8) s += red[(w8 * 4 + wave) * 64 + lane];
                mod[(size_t)(l * 4 + wave) * NMOD + col] = s + PIN(3)[l * NMOD + col]; }
            __syncthreads();
        }
    }
    {
        LAS float* scr = (LAS float*)((LAS unsigned char*)lds + 32768 + wave * 8448);
        const int gw = bid * 8 + wave, NGW = G * 8;
        constexpr int I_IN = 16 * 69, I_OUT = 16 * 32, I_F1 = 16 * 128, I_F2 = 64 * 32, I_UQ = 4 * 12, I_UKV = 2 * 16;
        constexpr int I_L = I_IN + I_OUT + I_F1 + I_F2 + I_UQ + I_UKV;
        for (int it = gw; it < 2 * I_L; it += NGW) {
            const int l = it / I_L; int r = it % I_L;
            if (r < I_IN) { transpose_item(PIN(6) + (size_t)l * 1024 * 2208, 1024, 2208, (bf16_t*)(ws + WS_WIN) + (size_t)l * NPROJ * 1024, scr, r, lane); continue; } r -= I_IN;
            if (r < I_OUT) { transpose_item(PIN(14) + (size_t)l * 1024 * 1024, 1024, 1024, (bf16_t*)(ws + WS_WOUT) + (size_t)l * 1024 * 1024, scr, r, lane); continue; } r -= I_OUT;
            if (r < I_F1) { transpose_item(PIN(15) + (size_t)l * 1024 * 4096, 1024, 4096, (bf16_t*)(ws + WS_WFF1) + (size_t)l * 4096 * 1024, scr, r, lane); continue; } r -= I_F1;
            if (r < I_F2) { transpose_item(PIN(16) + (size_t)l * 4096 * 1024, 4096, 1024, (bf16_t*)(ws + WS_WFF2) + (size_t)l * 1024 * 4096, scr, r, lane); continue; } r -= I_F2;
            if (r < I_UQ) { transpose_item(PIN(11) + (size_t)l * 256 * 384, 256, 384, (bf16_t*)(ws + WS_WUQ) + (size_t)l * 512 * 256, scr, r, lane); continue; } r -= I_UQ;
            transpose_item(PIN(12) + (size_t)l * 128 * 512, 128, 512, (bf16_t*)(ws + WS_WUKV) + (size_t)l * 512 * 128, scr, r, lane);
        }
        const int gt = bid * 512 + tid, NT = G * 512;
        const u32x4 z = {0u, 0u, 0u, 0u};
        for (int i = gt; i < 2 * 96 * 128; i += NT) { const int l = i / (96 * 128), r = i % (96 * 128); *(u32x4*)((bf16_t*)(ws + WS_WIN) + (size_t)l * NPROJ * 1024 + (size_t)2208 * 1024 + (size_t)r * 8) = z; }
        for (int i = gt; i < 2 * 128 * 32; i += NT) { const int l = i / (128 * 32), r = i % (128 * 32); *(u32x4*)((bf16_t*)(ws + WS_WUQ) + (size_t)l * 512 * 256 + (size_t)384 * 256 + (size_t)r * 8) = z; }
        { float* ssq = (float*)(ws + WS_SSQ); for (int i = gt; i < 2 * T_TOK; i += NT) ssq[i] = 0.f; }
        { float* ssq = (float*)(ws + WS_SSQ1); for (int i = gt; i < 2 * T_TOK; i += NT) ssq[i] = 0.f; }
        float2* csax = (float2*)(ws + WS_CSAX); float2* csdil = (float2*)(ws + WS_CSDIL); float2* csmla = (float2*)(ws + WS_CSMLA);
        for (int i = gt; i < SEQ * 32; i += NT) {
            const int t = i >> 5, e = i & 31;
            csdil[i] = cs_of((double)t * INV64[e]);
            const int pos = (e < 16) ? (t >> 6) : (t & 63);
            csax[i] = cs_of((double)pos * INV64[2 * (e & 15)]);
            if (e < 16) csmla[t * 16 + e] = cs_of((double)t * INV64[2 * e]);
        }
    }
}

DI void vecmat4(const float* vec, int vstride, const float* W, int N, int nitems, float* out, int ostride, unsigned char* lds, int bid, int G, int tid, int lane, int wave) {
    float* sv = (float*)lds; float* red = (float*)(lds + 16384);
    for (int i = tid; i < 4096; i += 512) sv[i] = vec[(size_t)(i >> 10) * vstride + (i & 1023)];
    __syncthreads();
    for (int item = bid; item < nitems; item += G) {
        const int col = item * 64 + lane; const bool cin = (col < N);
        const float* Wc = W + (cin ? col : 0);
        float a0 = 0.f, a1 = 0.f, a2 = 0.f, a3 = 0.f;
        const int k0 = wave * 128;
#pragma unroll 8
        for (int k = k0; k < k0 + 128; ++k) { const float w = cin ? Wc[(size_t)k * N] : 0.f; a0 += sv[k] * w; a1 += sv[1024 + k] * w; a2 += sv[2048 + k] * w; a3 += sv[3072 + k] * w; }
        red[(wave * 4 + 0) * 64 + lane] = a0; red[(wave * 4 + 1) * 64 + lane] = a1; red[(wave * 4 + 2) * 64 + lane] = a2; red[(wave * 4 + 3) * 64 + lane] = a3;
        __syncthreads();
        if (wave < 4) { float t = 0.f;
#pragma unroll
            for (int w8 = 0; w8 < 8; ++w8) t += red[(w8 * 4 + wave) * 64 + lane];
            out[(size_t)wave * ostride + col] = t; }
        __syncthreads();
    }
}
DI void phase_norm_mod(const float* xin, const float* nw, const float* modl, int sh_off, int sc_off, bf16_t* H, int gw, int NGW, int lane) {
    for (int row = gw; row < T_TOK; row += NGW) {
        const f32x4* xr = (const f32x4*)(xin + (size_t)row * DM) + lane;
        f32x4 v[4]; float ss = 0.f;
#pragma unroll
        for (int j = 0; j < 4; ++j) { v[j] = xr[64 * j]; ss += (v[j].x * v[j].x + v[j].y * v[j].y) + (v[j].z * v[j].z + v[j].w * v[j].w); }
        const float rs = 1.0f / sqrtf(wave_sum(ss) * (1.f / DM) + EPS);
        const float* mb = modl + (size_t)(row >> 12) * NMOD;
        unsigned long long* o8 = (unsigned long long*)(H + (size_t)row * DM) + lane;
#pragma unroll
        for (int j = 0; j < 4; ++j) { const int col = 4 * (64 * j + lane);
            const f32x4 w = *(const f32x4*)(nw + col), s1 = *(const f32x4*)(mb + sc_off + col), s0 = *(const f32x4*)(mb + sh_off + col);
            const f32x4 y = (v[j] * rs * w) * (s1 + 1.0f) + s0;
            o8[64 * j] = (unsigned long long)pk2(y.x, y.y) | ((unsigned long long)pk2(y.z, y.w) << 32); }
    }
}
DI void phase_prenorm(const float* xin, const float* nw, const float* modl, int sc_off, bf16_t* H, float* ssq, int gw, int NGW, int lane) {
    for (int row = gw; row < T_TOK; row += NGW) {
        const f32x4* xr = (const f32x4*)(xin + (size_t)row * DM) + lane;
        f32x4 v[4]; float ss = 0.f;
#pragma unroll
        for (int j = 0; j < 4; ++j) { v[j] = xr[64 * j]; ss += (v[j].x * v[j].x + v[j].y * v[j].y) + (v[j].z * v[j].z + v[j].w * v[j].w); }
        ss = wave_sum(ss);
        if (lane == 0) ssq[row] = ss;
        const float* mb = modl + (size_t)(row >> 12) * NMOD;
        unsigned long long* o8 = (unsigned long long*)(H + (size_t)row * DM) + lane;
#pragma unroll
        for (int j = 0; j < 4; ++j) { const int col = 4 * (64 * j + lane);
            const f32x4 w = *(const f32x4*)(nw + col), s1 = *(const f32x4*)(mb + sc_off + col);
            const f32x4 y = (v[j] * w) * (s1 + 1.0f);
            o8[64 * j] = (unsigned long long)pk2(y.x, y.y) | ((unsigned long long)pk2(y.z, y.w) << 32); }
    }
}
DI void phase_final_norm(float* xio, const float* nw, int gw, int NGW, int lane) {
    for (int row = gw; row < T_TOK; row += NGW) {
        f32x4* xr = (f32x4*)(xio + (size_t)row * DM) + lane;
        f32x4 v[4]; float ss = 0.f;
#pragma unroll
        for (int j = 0; j < 4; ++j) { v[j] = xr[64 * j]; ss += (v[j].x * v[j].x + v[j].y * v[j].y) + (v[j].z * v[j].z + v[j].w * v[j].w); }
        const float rs = 1.0f / sqrtf(wave_sum(ss) * (1.f / DM) + EPS);
#pragma unroll
        for (int j = 0; j < 4; ++j) { const f32x4 w = *(const f32x4*)(nw + 4 * (64 * j + lane)); xr[64 * j] = v[j] * rs * w; }
    }
}
typedef short bfx8 __attribute__((ext_vector_type(8)));
DI void ld8f(const bf16_t* p, float (&x)[8]) { const bfx8 v = *(const bfx8*)p;
#pragma unroll
    for (int e = 0; e < 8; ++e) x[e] = bf2f((bf16_t)v[e]); }
DI void st8f(bf16_t* p, const float (&x)[8]) { u32x4 w; w.x = pk2(x[0], x[1]); w.y = pk2(x[2], x[3]); w.z = pk2(x[4], x[5]); w.w = pk2(x[6], x[7]); *(u32x4*)p = w; }
DI void ldcs8(const float2* t, float (&c)[8], float (&s)[8]) {
#pragma unroll
    for (int q = 0; q < 4; ++q) { const f32x4 v = *((const f32x4*)t + q); c[2 * q] = v.x; s[2 * q] = v.y; c[2 * q + 1] = v.z; s[2 * q + 1] = v.w; } }
template <int XM> DI void rope8(float (&x)[8], const float (&c)[8], const float (&s)[8], bool lo) {
#pragma unroll
    for (int e = 0; e < 8; ++e) { const float pr = __shfl_xor(x[e], XM); x[e] = lo ? (x[e] * c[e] - pr * s[e]) : (pr * s[e] + x[e] * c[e]); } }
DI void phase_post(int l, int gw, int NGW, int lane) {
    unsigned char* ws = PWS;
    bf16_t* proj = (bf16_t*)(ws + WS_PROJ); bf16_t* bqn = (bf16_t*)(ws + WS_BQN); bf16_t* bkvn = (bf16_t*)(ws + WS_BKVN);
    const float2* csax = (const float2*)(ws + WS_CSAX); const float2* csdil = (const float2*)(ws + WS_CSDIL); const float2* csmla = (const float2*)(ws + WS_CSMLA);
    const int j8 = lane & 7;
    float g1[8], g4[8];
    { const float* gp = (lane < 48) ? (PIN(7) + l * 64 + 8 * j8) : (PIN(8) + l * 64 + 8 * j8);
      const float* g4p = (lane < 32) ? (PIN(9) + l * 256 + 8 * lane) : (PIN(10) + l * 128 + 8 * (lane & 15));
#pragma unroll
      for (int e = 0; e < 8; ++e) { g1[e] = gp[e]; g4[e] = g4p[e]; } }
    const float sc1 = (lane < 48) ? QSCALE64 : 1.0f;
    const bool lo = (j8 < 4);
    for (int row = gw; row < T_TOK; row += NGW) {
        const int t = row & (SEQ - 1);
        bf16_t* pr = proj + (size_t)row * NPROJ;
        float x1[8], x2[8], x3[8], x4[8], c[8], s[8];
        ld8f(pr + 8 * lane, x1);
        if (lane < 48) { ld8f(pr + C_CQ + 8 * lane, x2); ld8f(pr + C_CK + 8 * lane, x3); }
        else {
#pragma unroll
            for (int e = 0; e < 8; ++e) { x2[e] = 0.f; x3[e] = 0.f; } }
        const bf16_t* p4 = (lane < 32) ? (pr + C_BQ + 8 * lane) : (lane < 48) ? (pr + C_BKV + 8 * (lane - 32)) : (pr + C_BKR + 8 * (lane & 3));
        ld8f(p4, x4);
        { float ss = 0.f;
#pragma unroll
          for (int e = 0; e < 8; ++e) ss += x1[e] * x1[e];
          ss += __shfl_xor(ss, 1); ss += __shfl_xor(ss, 2); ss += __shfl_xor(ss, 4);
          const float rs = 1.0f / sqrtf(ss * (1.f / 64.f) + EPS);
#pragma unroll
          for (int e = 0; e < 8; ++e) x1[e] = x1[e] * rs * g1[e];
          ldcs8(csax + t * 32 + 8 * (j8 & 3), c, s);
          rope8<4>(x1, c, s, lo);
#pragma unroll
          for (int e = 0; e < 8; ++e) x1[e] *= sc1;
          st8f(pr + 8 * lane, x1); }
        { ldcs8(csdil + t * 32 + 8 * (j8 & 3), c, s);
          rope8<4>(x2, c, s, lo); rope8<4>(x3, c, s, lo);
#pragma unroll
          for (int e = 0; e < 8; ++e) x2[e] *= QSCALE64;
          if (lane < 48) { st8f(pr + C_CQ + 8 * lane, x2); st8f(pr + C_CK + 8 * lane, x3); } }
        { float ss = 0.f;
          if (lane < 48) {
#pragma unroll
              for (int e = 0; e < 8; ++e) ss += x4[e] * x4[e]; }
          ss += __shfl_xor(ss, 1); ss += __shfl_xor(ss, 2); ss += __shfl_xor(ss, 4); ss += __shfl_xor(ss, 8); ss += __shfl_xor(ss, 16);
          const float rs = 1.0f / sqrtf(ss * ((lane < 32) ? (1.f / 256.f) : (1.f / 128.f)) + EPS);
          float y[8];
#pragma unroll
          for (int e = 0; e < 8; ++e) y[e] = x4[e] * rs * g4[e];
          ldcs8(csmla + t * 16 + 8 * (lane & 1), c, s);
          rope8<2>(x4, c, s, (lane & 2) == 0);
          if (lane < 32) st8f(bqn + (size_t)row * 256 + 8 * lane, y);
          else if (lane < 48) st8f(bkvn + (size_t)row * 128 + 8 * (lane - 32), y);
          else if (lane < 52) st8f(pr + C_BKR + 8 * (lane & 3), x4); }
    }
}
DI void phase_merge(int l, int gw, int NGW, int lane) {
    unsigned char* ws = PWS;
    const bf16_t* yab = (const bf16_t*)(ws + WS_YAB); const bf16_t* yc = (const bf16_t*)(ws + WS_YC); const float* lse = (const float*)(ws + WS_LSE);
    bf16_t* H = (bf16_t*)(ws + WS_H);
    const float* gain = PIN(13) + l * 1024;
    const bool inA = (lane < 48), inB = (lane < 32);
    float gA[8], gB[8], gC[8];
#pragma unroll
    for (int e = 0; e < 8; ++e) { gA[e] = inA ? gain[8 * lane + e] : 0.f; gB[e] = inB ? gain[384 + 8 * lane + e] : 0.f; gC[e] = inA ? gain[640 + 8 * lane + e] : 0.f; }
    const int h = (lane >> 3) < 6 ? (lane >> 3) : 0;
    for (int row = gw; row < T_TOK; row += NGW) {
        bf16_t* hr = H + (size_t)row * DM;
        float a[8], b[8], x[8];
#pragma unroll
        for (int e = 0; e < 8; ++e) { a[e] = 0.f; b[e] = 0.f; x[e] = 0.f; }
        if (inA) ld8f(yab + (size_t)row * 640 + 8 * lane, a);
        if (inB) ld8f(yab + (size_t)row * 640 + 384 + 8 * lane, b);
        if (inA) {
            float c0[8], c1[8], c2[8];
            ld8f(yc + (size_t)row * 384 + 8 * lane, c0); ld8f(yc + (size_t)(T_TOK + row) * 384 + 8 * lane, c1); ld8f(yc + (size_t)(2 * T_TOK + row) * 384 + 8 * lane, c2);
            const float l0 = lse[(size_t)row * 6 + h], l1 = lse[(size_t)(T_TOK + row) * 6 + h], l2 = lse[(size_t)(2 * T_TOK + row) * 6 + h];
            const float mx = fmaxf(l0, fmaxf(l1, l2));
            const float w0 = __builtin_amdgcn_exp2f(l0 - mx), w1 = __builtin_amdgcn_exp2f(l1 - mx), w2 = __builtin_amdgcn_exp2f(l2 - mx);
            const float inv = 1.0f / (w0 + w1 + w2);
#pragma unroll
            for (int e = 0; e < 8; ++e) x[e] = (w0 * c0[e] + w1 * c1[e] + w2 * c2[e]) * inv;
        }
        float sa = 0.f, sb = 0.f, sc = 0.f;
#pragma unroll
        for (int e = 0; e < 8; ++e) { sa += a[e] * a[e]; sb += b[e] * b[e]; sc += x[e] * x[e]; }
        const float ra = 1.0f / sqrtf(wave_sum(sa) * (1.f / 384.f) + EPS), rb = 1.0f / sqrtf(wave_sum(sb) * (1.f / 256.f) + EPS), rc = 1.0f / sqrtf(wave_sum(sc) * (1.f / 384.f) + EPS);
#pragma unroll
        for (int e = 0; e < 8; ++e) { a[e] *= ra * gA[e]; b[e] *= rb * gB[e]; x[e] *= rc * gC[e]; }
        if (inA) { st8f(hr + 8 * lane, a); st8f(hr + 640 + 8 * lane, x); }
        if (inB) st8f(hr + 384 + 8 * lane, b);
    }
}

namespace att {
typedef short bf16x8 __attribute__((ext_vector_type(8)));
typedef short s16x4 __attribute__((ext_vector_type(4)));
typedef float f32x16 __attribute__((ext_vector_type(16)));
#define SBAR() __builtin_amdgcn_sched_barrier(0)
constexpr int KBUF = 13312, VBUF = 8192, OFF_V = 4 * KBUF, OFF_WS = OFF_V + 4 * VBUF, OFF_Q = OFF_WS + 8 * 256;
constexpr float THR2 = 11.5f;
DI int crow(int r, int hi) { return (r & 3) + 8 * (r >> 2) + 4 * hi; }
DI unsigned cvtpk(float lo, float hi) { unsigned r; asm volatile("v_cvt_pk_bf16_f32 %0, %1, %2" : "=v"(r) : "v"(lo), "v"(hi)); return r; }
DI int v_st(int k, int c) { return ((k >> 3) * 2 + (c >> 5)) * 512 + ((k & 7) * 32 + (c & 31)) * 2; }
DI int v_rd_base(int lane) { return ((lane & 3) << 3) | (((lane >> 2) & 3) << 6) | (((lane >> 4) & 1) << 5) | (((lane >> 5) & 1) << 8); }
template <int OFF> DI s16x4 tr_read(int vb) { s16x4 r; asm volatile("ds_read_b64_tr_b16 %0, %1 offset:%2" : "=&v"(r) : "v"(vb), "i"(OFF) : "memory"); return r; }
template <int D0> DI void pv_one(f32x16& od, int vb, bf16x8 pa0, bf16x8 pa1, bf16x8 pa2, bf16x8 pa3) {
    const s16x4 l0 = tr_read<D0 * 512 + 0>(vb), h0 = tr_read<D0 * 512 + 1024>(vb), l1 = tr_read<D0 * 512 + 2048>(vb), h1 = tr_read<D0 * 512 + 3072>(vb);
    const s16x4 l2 = tr_read<D0 * 512 + 4096>(vb), h2 = tr_read<D0 * 512 + 5120>(vb), l3 = tr_read<D0 * 512 + 6144>(vb), h3 = tr_read<D0 * 512 + 7168>(vb);
    asm volatile("s_waitcnt lgkmcnt(0)" ::: "memory"); SBAR();
#define PK(L, H) (bf16x8){L[0], L[1], L[2], L[3], H[0], H[1], H[2], H[3]}
    od = __builtin_amdgcn_mfma_f32_32x32x16_bf16(pa0, PK(l0, h0), od, 0, 0, 0);
    od = __builtin_amdgcn_mfma_f32_32x32x16_bf16(pa1, PK(l1, h1), od, 0, 0, 0);
    od = __builtin_amdgcn_mfma_f32_32x32x16_bf16(pa2, PK(l2, h2), od, 0, 0, 0);
    od = __builtin_amdgcn_mfma_f32_32x32x16_bf16(pa3, PK(l3, h3), od, 0, 0, 0);
#undef PK
}
struct Desc {
    const bf16_t* q; long ldq;
    const bf16_t* k; long ldk;
    const bf16_t* k2; long ldk2;
    const bf16_t* v; long ldv;
    bf16_t* o; long ldo;
    float* lse; long ldlse;
    const float2* qcs;
    int kt0, kt1, q0;
    unsigned* counter;
};

template <int DQ, bool BAND>
DI int attn_unit(const Desc& u, unsigned char* lds, int tid, int wid, int lane) {
    constexpr int NK = DQ / 16, KROW = DQ * 2 + 16;
    const int r32 = lane & 31, hi = lane >> 5;
    char* K_lds = (char*)lds; char* V_lds = (char*)lds + OFF_V;
    float* wsf = (float*)(lds + OFF_WS) + wid * 64; float* li_l = wsf; float* al_l = wsf + 32;
    const int skey = tid >> 3, sc = tid & 7;
    int k1key = 0, k1c = 0; const bool k1on = (DQ == 96) && (tid < 256);
    int k0key = skey, k0c = sc;
    if constexpr (DQ == 96) { k0key = tid / 12; k0c = tid % 12; const int i1 = tid + 512; k1key = i1 / 12; k1c = i1 % 12; }
    const int vdst = v_st(skey, sc * 8);
    const int vb0 = (int)(unsigned)(size_t)V_lds + v_rd_base(lane);
    bf16x8 kreg0A, kreg1A, vregA, kreg0B, kreg1B, vregB;
    const bool k0two = (DQ == 96) && (k0c >= 8), k1two = (DQ == 96) && (k1c >= 8);
    const bf16_t* kp0 = k0two ? u.k2 + (long)k0key * u.ldk2 + (k0c - 8) * 8 : u.k + (long)k0key * u.ldk + k0c * 8;
    const bf16_t* kp1 = k1two ? u.k2 + (long)k1key * u.ldk2 + (k1c - 8) * 8 : u.k + (long)k1key * u.ldk + k1c * 8;
    const long ks0 = 64 * (k0two ? u.ldk2 : u.ldk), ks1 = 64 * (k1two ? u.ldk2 : u.ldk);
    const bf16_t* vp = u.v + (long)skey * u.ldv + sc * 8; const long vs = 64 * u.ldv;
#define A_LOAD(S, kt) do { const long kt_ = (long)(kt); kreg0##S = *(const bf16x8*)(kp0 + kt_ * ks0); \
        if constexpr (DQ == 96) { if (k1on) kreg1##S = *(const bf16x8*)(kp1 + kt_ * ks1); } \
        vreg##S = *(const bf16x8*)(vp + kt_ * vs); } while (0)
#define A_WRITE(S, b) do { *(bf16x8*)(K_lds + (b) * KBUF + k0key * KROW + k0c * 16) = kreg0##S; \
        if constexpr (DQ == 96) { if (k1on) *(bf16x8*)(K_lds + (b) * KBUF + k1key * KROW + k1c * 16) = kreg1##S; } \
        *(bf16x8*)(V_lds + (b) * VBUF + vdst) = vreg##S; } while (0)
    float m_reg = 0.f, l_reg = 0.f;
    f32x16 o0, o1, negm;
#pragma unroll
    for (int r = 0; r < 16; ++r) { o0[r] = 0.f; o1[r] = 0.f; negm[r] = 0.f; }
    const int qrow = u.q0 + wid * 32 + r32;
    const int qmin = u.q0 + wid * 32;
    A_LOAD(A, u.kt0); if (u.kt0 + 1 < u.kt1) A_LOAD(B, u.kt0 + 1);
    bf16x8 qr[NK];
    { const bf16_t* Qw = u.q + (long)(wid * 32 + r32) * u.ldq + hi * 8;
#pragma unroll
      for (int d0 = 0; d0 < NK; ++d0) qr[d0] = *(const bf16x8*)(Qw + d0 * 16);
      if constexpr (DQ == 96) {
          const float2* cs = u.qcs + (long)(wid * 32 + r32) * 16 + hi * 8;
#pragma unroll
          for (int d0 = 0; d0 < 4; ++d0) { bf16x8 t = qr[d0];
#pragma unroll
              for (int j = 0; j < 8; ++j) t[j] = (short)f2bf(bf2f((bf16_t)t[j]) * QSCALE96);
              qr[d0] = t; }
          bf16x8 a = qr[4], b = qr[5];
#pragma unroll
          for (int j = 0; j < 8; ++j) { const float2 c = cs[j]; const float x1 = bf2f((bf16_t)a[j]), x2 = bf2f((bf16_t)b[j]);
              a[j] = (short)f2bf((x1 * c.x - x2 * c.y) * QSCALE96); b[j] = (short)f2bf((x1 * c.y + x2 * c.x) * QSCALE96); }
          qr[4] = a; qr[5] = b;
      } }
    A_WRITE(A, 0); if (u.kt0 + 1 < u.kt1) A_WRITE(B, 1);
    __syncthreads();
    int un_next = 0;
    if (tid == 0) un_next = (int)__hip_atomic_fetch_add(u.counter, 1u, __ATOMIC_RELAXED, __HIP_MEMORY_SCOPE_AGENT);
    int sb = 0;
    for (int kt0_ = u.kt0; kt0_ < u.kt1; kt0_ += 2) {
      const bool n1 = (kt0_ + 2 < u.kt1), n2 = (kt0_ + 3 < u.kt1);
      if (n1) A_LOAD(A, kt0_ + 2);
      if (n2) A_LOAD(B, kt0_ + 3);
#pragma unroll
      for (int sub = 0; sub < 2; ++sub) {
        const int kt = kt0_ + sub, buf = sb + sub;
        if (kt >= u.kt1) break;
        bool active = true;
        if constexpr (BAND) active = !((kt * 64 + 63 < qmin - 64) || (kt * 64 > qmin + 31 + 64));
        if (active) {
            f32x16 p0, p1;
            const char* Kb = K_lds + buf * KBUF;
#pragma unroll
            for (int d0 = 0; d0 < NK; ++d0) { const int cb = (d0 * 16 + hi * 8) * 2;
                const bf16x8 b0 = *(const bf16x8*)(Kb + r32 * KROW + cb);
                const bf16x8 b1 = *(const bf16x8*)(Kb + (32 + r32) * KROW + cb);
                if (d0 == 0) { p0 = __builtin_amdgcn_mfma_f32_32x32x16_bf16(b0, qr[0], negm, 0, 0, 0); p1 = __builtin_amdgcn_mfma_f32_32x32x16_bf16(b1, qr[0], negm, 0, 0, 0); }
                else { p0 = __builtin_amdgcn_mfma_f32_32x32x16_bf16(b0, qr[d0], p0, 0, 0, 0); p1 = __builtin_amdgcn_mfma_f32_32x32x16_bf16(b1, qr[d0], p1, 0, 0, 0); } }
            if constexpr (BAND) {
                const int kb = kt * 64 + 4 * hi - qrow;
#pragma unroll
                for (int r = 0; r < 16; ++r) { const int dk = kb + (r & 3) + 8 * (r >> 2);
                    if (dk < -64 || dk > 64) p0[r] = -INFINITY;
                    if (dk + 32 < -64 || dk + 32 > 64) p1[r] = -INFINITY; }
            }
            float pmax = p0[0];
#pragma unroll
            for (int r = 1; r < 16; ++r) pmax = fmaxf(pmax, p0[r]);
#pragma unroll
            for (int r = 0; r < 16; ++r) pmax = fmaxf(pmax, p1[r]);
            pmax = fmaxf(pmax, __shfl_xor(pmax, 32));
            float alpha = 1.f;
            const bool first = (kt == u.kt0);
            if (first || !__all(pmax <= THR2)) {
                const float d = first ? pmax : fmaxf(pmax, 0.f);
                alpha = first ? 1.f : __builtin_amdgcn_exp2f(-d); m_reg += d;
#pragma unroll
                for (int r = 0; r < 16; ++r) { p0[r] -= d; p1[r] -= d; negm[r] = -m_reg; }
            }
            float ps = 0.f;
#pragma unroll
            for (int r = 0; r < 16; ++r) { p0[r] = __builtin_amdgcn_exp2f(p0[r]); p1[r] = __builtin_amdgcn_exp2f(p1[r]); ps += p0[r] + p1[r]; }
            ps += __shfl_xor(ps, 32);
            l_reg = l_reg * alpha + ps;
            if (__any(alpha < 1.f)) {
                if (hi == 0) al_l[r32] = alpha;
                asm volatile("s_waitcnt lgkmcnt(0)" ::: "memory");
#pragma unroll
                for (int r = 0; r < 16; ++r) { const float a = al_l[crow(r, hi)]; o0[r] *= a; o1[r] *= a; }
            }
            bf16x8 pa0, pa1, pa2, pa3;
#define PK4(P, BASE, OUT) do { u32x4 w = {cvtpk(P[BASE + 0], P[BASE + 1]), cvtpk(P[BASE + 2], P[BASE + 3]), cvtpk(P[BASE + 4], P[BASE + 5]), cvtpk(P[BASE + 6], P[BASE + 7])}; \
    OUT = *reinterpret_cast<bf16x8*>(&w); } while (0)
            PK4(p0, 0, pa0); PK4(p0, 8, pa1); PK4(p1, 0, pa2); PK4(p1, 8, pa3);
#undef PK4
            const int vb = vb0 + buf * VBUF;
            pv_one<0>(o0, vb, pa0, pa1, pa2, pa3);
            pv_one<1>(o1, vb, pa0, pa1, pa2, pa3);
        }
      }
      if (n1) A_WRITE(A, sb ^ 2);
      if (n2) A_WRITE(B, (sb ^ 2) + 1);
      __syncthreads();
      sb ^= 2;
    }
#undef A_LOAD
#undef A_WRITE
    if (hi == 0) li_l[r32] = l_reg;
    asm volatile("s_waitcnt lgkmcnt(0)" ::: "memory");
    bf16_t* Ow = u.o + (long)(wid * 32) * u.ldo;
#pragma unroll
    for (int r = 0; r < 16; ++r) { const int orow = crow(r, hi); const float rl = 1.0f / li_l[orow];
        Ow[(long)orow * u.ldo + r32] = (bf16_t)f2bf(o0[r] * rl);
        Ow[(long)orow * u.ldo + 32 + r32] = (bf16_t)f2bf(o1[r] * rl); }
    if constexpr (BAND) { if (hi == 0) u.lse[(long)(wid * 32 + r32) * u.ldlse] = m_reg + __builtin_amdgcn_logf(l_reg); }
    asm volatile("s_waitcnt lgkmcnt(0)" ::: "memory");
    return un_next;
}

DI int attn_unit_band(const Desc& u, unsigned char* lds, int tid, int wid, int lane) {
    constexpr int DQ = 64, NK = 4, KROW = 144, KB = 9216, VB = 8192, OFFV = 6 * KB, OFFS = OFFV + 6 * VB;
    const int r32 = lane & 31, hi = lane >> 5;
    char* K_lds = (char*)lds; char* V_lds = (char*)lds + OFFV;
    float* wsf = (float*)(lds + OFFS) + wid * 64; float* li_l = wsf; float* al_l = wsf + 32;
    const int skey = tid >> 3, sc = tid & 7;
    const int vdst = v_st(skey, sc * 8);
    const int vb0 = (int)(unsigned)(size_t)V_lds + v_rd_base(lane);
    const int nt = u.kt1 - u.kt0;
    bf16x8 kr[6], vr[6];
#pragma unroll
    for (int i = 0; i < 6; ++i) if (i < nt) { const long kb_ = (long)(u.kt0 + i) * 64;
        kr[i] = *(const bf16x8*)(u.k + (kb_ + skey) * u.ldk + sc * 8); vr[i] = *(const bf16x8*)(u.v + (kb_ + skey) * u.ldv + sc * 8); }
    bf16x8 qr[NK];
    { const bf16_t* Qw = u.q + (long)(wid * 32 + r32) * u.ldq + hi * 8;
#pragma unroll
      for (int d0 = 0; d0 < NK; ++d0) qr[d0] = *(const bf16x8*)(Qw + d0 * 16); }
#pragma unroll
    for (int i = 0; i < 6; ++i) if (i < nt) { *(bf16x8*)(K_lds + i * KB + skey * KROW + sc * 16) = kr[i]; *(bf16x8*)(V_lds + i * VB + vdst) = vr[i]; }
    float m_reg = 0.f, l_reg = 0.f; bool started = false;
    f32x16 o0, o1, negm;
#pragma unroll
    for (int r = 0; r < 16; ++r) { o0[r] = 0.f; o1[r] = 0.f; negm[r] = 0.f; }
    const int qrow = u.q0 + wid * 32 + r32;
    const int qmin = u.q0 + wid * 32;
    __syncthreads();
    int un_next = 0;
    if (tid == 0) un_next = (int)__hip_atomic_fetch_add(u.counter, 1u, __ATOMIC_RELAXED, __HIP_MEMORY_SCOPE_AGENT);
    for (int kt = u.kt0; kt < u.kt1; ++kt) {
        const int buf = kt - u.kt0;
        bool active = true;
        active = !((kt * 64 + 63 < qmin - 64) || (kt * 64 > qmin + 31 + 64));
        if (active) {
            f32x16 p0, p1;
            const char* Kb = K_lds + buf * KB;
#pragma unroll
            for (int d0 = 0; d0 < NK; ++d0) { const int cb = (d0 * 16 + hi * 8) * 2;
                const bf16x8 b0 = *(const bf16x8*)(Kb + r32 * KROW + cb);
                const bf16x8 b1 = *(const bf16x8*)(Kb + (32 + r32) * KROW + cb);
                if (d0 == 0) { p0 = __builtin_amdgcn_mfma_f32_32x32x16_bf16(b0, qr[0], negm, 0, 0, 0); p1 = __builtin_amdgcn_mfma_f32_32x32x16_bf16(b1, qr[0], negm, 0, 0, 0); }
                else { p0 = __builtin_amdgcn_mfma_f32_32x32x16_bf16(b0, qr[d0], p0, 0, 0, 0); p1 = __builtin_amdgcn_mfma_f32_32x32x16_bf16(b1, qr[d0], p1, 0, 0, 0); } }
            {
                const int kb = kt * 64 + 4 * hi - qrow;
#pragma unroll
                for (int r = 0; r < 16; ++r) { const int dk = kb + (r & 3) + 8 * (r >> 2);
                    if (dk < -64 || dk > 64) p0[r] = -INFINITY;
                    if (dk + 32 < -64 || dk + 32 > 64) p1[r] = -INFINITY; }
            }
            float pmax = p0[0];
#pragma unroll
            for (int r = 1; r < 16; ++r) pmax = fmaxf(pmax, p0[r]);
#pragma unroll
            for (int r = 0; r < 16; ++r) pmax = fmaxf(pmax, p1[r]);
            pmax = fmaxf(pmax, __shfl_xor(pmax, 32));
            float alpha = 1.f;
            const bool first = !started; started = true;
            if (first || !__all(pmax <= THR2)) {
                const float d = first ? pmax : fmaxf(pmax, 0.f);
                alpha = first ? 1.f : __builtin_amdgcn_exp2f(-d); m_reg += d;
#pragma unroll
                for (int r = 0; r < 16; ++r) { p0[r] -= d; p1[r] -= d; negm[r] = -m_reg; }
            }
            float ps = 0.f;
#pragma unroll
            for (int r = 0; r < 16; ++r) { p0[r] = __builtin_amdgcn_exp2f(p0[r]); p1[r] = __builtin_amdgcn_exp2f(p1[r]); ps += p0[r] + p1[r]; }
            ps += __shfl_xor(ps, 32);
            l_reg = l_reg * alpha + ps;
            if (__any(alpha < 1.f)) {
                if (hi == 0) al_l[r32] = alpha;
                asm volatile("s_waitcnt lgkmcnt(0)" ::: "memory");
#pragma unroll
                for (int r = 0; r < 16; ++r) { const float a = al_l[crow(r, hi)]; o0[r] *= a; o1[r] *= a; }
            }
            bf16x8 pa0, pa1, pa2, pa3;
#define PK4(P, BASE, OUT) do { u32x4 w = {cvtpk(P[BASE + 0], P[BASE + 1]), cvtpk(P[BASE + 2], P[BASE + 3]), cvtpk(P[BASE + 4], P[BASE + 5]), cvtpk(P[BASE + 6], P[BASE + 7])}; \
    OUT = *reinterpret_cast<bf16x8*>(&w); } while (0)
            PK4(p0, 0, pa0); PK4(p0, 8, pa1); PK4(p1, 0, pa2); PK4(p1, 8, pa3);
#undef PK4
            const int vb = vb0 + buf * VB;
            pv_one<0>(o0, vb, pa0, pa1, pa2, pa3);
            pv_one<1>(o1, vb, pa0, pa1, pa2, pa3);
        }
    }
    if (hi == 0) li_l[r32] = l_reg;
    asm volatile("s_waitcnt lgkmcnt(0)" ::: "memory");
    bf16_t* Ow = u.o + (long)(wid * 32) * u.ldo;
#pragma unroll
    for (int r = 0; r < 16; ++r) { const int orow = crow(r, hi); const float rl = 1.0f / li_l[orow];
        Ow[(long)orow * u.ldo + r32] = (bf16_t)f2bf(o0[r] * rl);
        Ow[(long)orow * u.ldo + 32 + r32] = (bf16_t)f2bf(o1[r] * rl); }
    { if (hi == 0) u.lse[(long)(wid * 32 + r32) * u.ldlse] = m_reg + __builtin_amdgcn_logf(l_reg); }
    asm volatile("s_waitcnt lgkmcnt(0)" ::: "memory");
    __syncthreads();
    return un_next;
}
}

constexpr int NU_B = 4 * 4 * 16, NU_A = 4 * 6 * 16, NU_C = 4 * 6 * 48, NU_ALL = NU_B + NU_A + NU_C;
DI void phase_attention(unsigned* counter, unsigned char* lds, int tid, int wid, int lane) {
    unsigned char* ws = PWS;
    const bf16_t* proj = (const bf16_t*)(ws + WS_PROJ); const bf16_t* qb = (const bf16_t*)(ws + WS_QB); const bf16_t* kvb = (const bf16_t*)(ws + WS_KVB);
    bf16_t* yab = (bf16_t*)(ws + WS_YAB); bf16_t* yc = (bf16_t*)(ws + WS_YC); float* lse = (float*)(ws + WS_LSE);
    volatile int* slot = (volatile int*)(lds + att::OFF_Q);
    if (tid == 0) *slot = (int)__hip_atomic_fetch_add(counter, 1u, __ATOMIC_RELAXED, __HIP_MEMORY_SCOPE_AGENT);
    __syncthreads();
    int un = __builtin_amdgcn_readfirstlane(*slot);
    __syncthreads();
    for (;;) {
        if (un >= NU_ALL) break;
        int un_next;
        int tid_u = tid; asm volatile("" : "+v"(tid_u)); const int lane_u = tid_u & 63;
        att::Desc d;
        d.k2 = nullptr; d.ldk2 = 0; d.lse = nullptr; d.ldlse = 0; d.qcs = nullptr; d.q0 = 0; d.counter = counter;
        if (un < NU_B) {
            const int b = un >> 6, h = (un >> 4) & 3, blk = un & 15; const long tok = (long)b * SEQ + blk * 256;
            d.q = qb + tok * 384 + h * 96; d.ldq = 384;
            d.k = kvb + (long)b * SEQ * 512 + h * 128; d.ldk = 512;
            d.k2 = proj + (long)b * SEQ * NPROJ + C_BKR; d.ldk2 = NPROJ;
            d.v = kvb + (long)b * SEQ * 512 + h * 128 + 64; d.ldv = 512;
            d.o = yab + tok * 640 + 384 + h * 64; d.ldo = 640;
            d.qcs = (const float2*)(ws + WS_CSMLA) + (long)(blk * 256) * 16;
            d.kt0 = 0; d.kt1 = SEQ / 64;
            un_next = att::attn_unit<96, false>(d, lds, tid_u, wid, lane_u);
        } else if (un < NU_B + NU_A) {
            const int v = un - NU_B; const int b = v / 96, h = (v / 16) % 6, blk = v & 15; const long tok = (long)b * SEQ + blk * 256;
            d.q = proj + tok * NPROJ + C_AQ + h * 64; d.ldq = NPROJ;
            d.k = proj + (long)b * SEQ * NPROJ + C_AK + (h / 3) * 64; d.ldk = NPROJ;
            d.v = proj + (long)b * SEQ * NPROJ + C_AV + (h / 3) * 64; d.ldv = NPROJ;
            d.o = yab + tok * 640 + h * 64; d.ldo = 640;
            d.kt0 = 0; d.kt1 = SEQ / 64;
            un_next = att::attn_unit<64, false>(d, lds, tid_u, wid, lane_u);
        } else {
            const int v = un - NU_B - NU_A; const int bh = v / 48, w = v % 48; const int b = bh / 6, h = bh % 6;
            int br, r, blk, dil;
            if (w < 16) { br = 0; r = 0; blk = w; dil = 1; } else if (w < 32) { br = 1; r = (w - 16) >> 2; blk = (w - 16) & 3; dil = 4; } else { br = 2; r = w - 32; blk = 0; dil = 16; }
            const int L = SEQ / dil; const long tok0 = (long)b * SEQ + r; const long tq = tok0 + (long)blk * 256 * dil;
            d.q = proj + tq * NPROJ + C_CQ + h * 64; d.ldq = (long)dil * NPROJ;
            d.k = proj + tok0 * NPROJ + C_CK + h * 64; d.ldk = (long)dil * NPROJ;
            d.v = proj + tok0 * NPROJ + C_CV + h * 64; d.ldv = (long)dil * NPROJ;
            d.o = yc + ((long)br * T_TOK + tq) * 384 + h * 64; d.ldo = (long)dil * 384;
            d.lse = lse + ((long)br * T_TOK + tq) * 6 + h; d.ldlse = (long)dil * 6;
            d.q0 = blk * 256;
            d.kt0 = (blk * 4 - 1 < 0) ? 0 : blk * 4 - 1; d.kt1 = (blk * 4 + 5 > L / 64) ? L / 64 : blk * 4 + 5;
            un_next = att::attn_unit_band(d, lds, tid_u, wid, lane_u);
        }
        if (tid == 0) *slot = un_next;
        __syncthreads();
        un = __builtin_amdgcn_readfirstlane(*slot);
        __syncthreads();
    }
}

#define XB_TMO      128
#define XB_XCNT(j)  (256  + 64 * (j))
#define XB_XSUB(j)  (1280 + 64 * (j))
#define XB_XGEN(j)  (2304 + 64 * (j))
#define XB_TOP      3328
#define XB_TOPGEN   3392
#define XCD_BAR_WORDS 3456
#define XB_SPIN_CAP (1u << 18)

__device__ __forceinline__ unsigned xb_ld(unsigned* p)              { return __hip_atomic_load(p, __ATOMIC_RELAXED, __HIP_MEMORY_SCOPE_AGENT); }
__device__ __forceinline__ unsigned xb_add(unsigned* p, unsigned v) { return __hip_atomic_fetch_add(p, v, __ATOMIC_RELAXED, __HIP_MEMORY_SCOPE_AGENT); }
__device__ __forceinline__ unsigned xb_xcc_id() { return (unsigned)__builtin_amdgcn_s_getreg((3 << 11) | 20) & 0xFu; }
#define XB_SPIN(cond, bar) do { unsigned _sp = 0; while (cond) { __builtin_amdgcn_s_sleep(1); \
    if ((++_sp & 255u) == 0u) { if (xb_ld(&(bar)[XB_TMO])) break; if (_sp > XB_SPIN_CAP) { atomicAdd(&(bar)[XB_TMO], 1u); break; } } } } while (0)

struct XcdBarrier {
    unsigned* bar; unsigned x;
    volatile LAS unsigned* st;
};

__device__ __forceinline__ XcdBarrier xcd_barrier_post(unsigned* bar, volatile LAS unsigned* st) {
    XcdBarrier b; b.bar = bar; b.x = xb_xcc_id(); b.st = st;
    if (threadIdx.x == 0) (void)xb_add(&bar[XB_XCNT(b.x)], 1u);
    return b;
}
__device__ __forceinline__ void xcd_barrier_complete(unsigned* bar, unsigned x, unsigned& nloc, unsigned& nx) {
    const unsigned G = gridDim.x * gridDim.y * gridDim.z;
    unsigned sum, cnt, mine, sp = 0u;
    for (;;) {
        sum = 0u; cnt = 0u; mine = 0u;
#pragma unroll
        for (unsigned j = 0; j < 16; ++j) { const unsigned c = xb_ld(&bar[XB_XCNT(j)]); sum += c; cnt += (c > 0u) ? 1u : 0u; mine = (j == x) ? c : mine; }
        if (sum == G) break;
        __builtin_amdgcn_s_sleep(1);
        if ((++sp & 255u) == 0u) { if (xb_ld(&bar[XB_TMO])) break; if (sp > XB_SPIN_CAP) { atomicAdd(&bar[XB_TMO], 1u); break; } }
    }
    nloc = mine > 0u ? mine : 1u; nx = cnt > 0u ? cnt : 1u;
}

__device__ __forceinline__ void xcd_barrier(const XcdBarrier& b) {
    asm volatile("s_waitcnt vmcnt(0)" ::: "memory");
    __syncthreads();
    if (threadIdx.x == 0) {
        unsigned* bar = b.bar;
        __builtin_amdgcn_s_waitcnt(0);
        unsigned nloc = b.st[0], nx = b.st[1];
        if (nloc == 0u) { xcd_barrier_complete(bar, b.x, nloc, nx); b.st[0] = nloc; b.st[1] = nx; }
        const unsigned old = xb_add(&bar[XB_XSUB(b.x)], 1u);
        const unsigned gen = old / nloc;
        if (old + 1u == (gen + 1u) * nloc) {
            __builtin_amdgcn_fence(__ATOMIC_RELEASE, "agent");
            asm volatile("s_waitcnt vmcnt(0)" ::: "memory");
            const unsigned og = xb_add(&bar[XB_TOP], 1u);
            const unsigned tg = og / nx;
            if (og + 1u == (tg + 1u) * nx) xb_add(&bar[XB_TOPGEN], 1u);
            else XB_SPIN(xb_ld(&bar[XB_TOPGEN]) == tg, bar);
            __builtin_amdgcn_fence(__ATOMIC_ACQUIRE, "agent");
            xb_add(&bar[XB_XGEN(b.x)], 1u);
            asm volatile("s_waitcnt vmcnt(0)" ::: "memory");
        } else {
            XB_SPIN(xb_ld(&bar[XB_XGEN(b.x)]) == gen, bar);
            __builtin_amdgcn_fence(__ATOMIC_ACQUIRE, "agent");
            asm volatile("s_waitcnt vmcnt(0)" ::: "memory");
        }
    }
    __syncthreads();
}

__global__ void __launch_bounds__(512, 2) mega_fwd(Params p) {
    extern __shared__ __attribute__((aligned(16))) unsigned char lds[];
    cg::grid_group grid = cg::this_grid();
    const int tid = threadIdx.x, lane = tid & 63, wave = __builtin_amdgcn_readfirstlane(tid >> 6);
    const int bid = blockIdx.x, G = gridDim.x;
    const int gw = bid * 8 + wave, NGW = G * 8;
    unsigned char* ws = PWS;
    PG8_LAS unsigned char* lds3 = (PG8_LAS unsigned char*)lds;
    bf16_t* H = (bf16_t*)(ws + WS_H);
    const float* mod = (const float*)(ws + WS_MOD);

    volatile LAS unsigned* bst = (volatile LAS unsigned*)((LAS unsigned char*)lds + 139264);
    if (tid < 2) bst[tid] = 0u;
    __syncthreads();
    const XcdBarrier xbar = xcd_barrier_post((unsigned*)(ws + WS_CTL) + 1024, bst);
    phase_prologue(lds, bid, G, tid, lane, wave);
    grid.sync();
#define GRID_SYNC() xcd_barrier(xbar)

#define FRESH_IDS() int tid_f = threadIdx.x; asm volatile("" : "+v"(tid_f)); const int lane_f = tid_f & 63, wave_f = __builtin_amdgcn_readfirstlane(tid_f >> 6), gw_f = bid * 8 + wave_f; (void)lane_f; (void)gw_f
    for (int l = 0; l < 2; ++l) {
        const float* modl = mod + (size_t)l * 4 * NMOD;
        const float* xin = (l == 0) ? PIN(0) : POUT;
        if (l == 0) {
            FRESH_IDS(); phase_prenorm(xin, PIN(4), modl, 1024, H, (float*)(ws + WS_SSQ1), gw_f, NGW, lane_f);
#pragma unroll 1
            for (int ll = 0; ll < 2; ++ll) { const float* ml = mod + (size_t)ll * 4 * NMOD;
                vecmat4(ml, NMOD, PIN(6) + (size_t)ll * 1024 * 2208, 2208, 36, (float*)(ws + WS_BIAS1) + (size_t)ll * 4 * NPROJ, NPROJ, lds, (bid + G - (ll * 100) % G) % G, G, tid_f, lane_f, wave_f);
                vecmat4(ml + 3072, NMOD, PIN(15) + (size_t)ll * 1024 * DFF, DFF, DFF / 64, (float*)(ws + WS_BIAS2) + (size_t)ll * 4 * DFF, DFF, lds, (bid + G - (36 + ll * 100) % G) % G, G, tid_f, lane_f, wave_f); }
            GRID_SYNC();
        }
        { pg8::Gemm g{H, (const bf16_t*)(ws + WS_WIN) + (size_t)l * NPROJ * 1024, T_TOK, 2048, DM}; pg8::StaticOrder S; S.init(T_TOK, 2048, G, bid);
          pg8::EpiStoreRS<0> E{(bf16_t*)(ws + WS_PROJ), NPROJ, (const float*)(ws + WS_SSQ1) + (size_t)l * T_TOK, (const float*)(ws + WS_BIAS1) + (size_t)l * 4 * NPROJ, NPROJ};
          pg8::gemm_phase<pg8::EpiStoreRS<0>, pg8::StaticOrder, true, true>(lds3, g, S, E); }
        GRID_SYNC();
        { const int nbig = G / 4;
          if (bid < nbig) { pg8::Gemm g{H, (const bf16_t*)(ws + WS_WIN) + (size_t)l * NPROJ * 1024 + (size_t)2048 * 1024, T_TOK, 256, DM}; pg8::StaticOrder S; S.init(T_TOK, 256, nbig, bid);
              pg8::EpiStoreRS<0> E{(bf16_t*)(ws + WS_PROJ) + 2048, NPROJ, (const float*)(ws + WS_SSQ1) + (size_t)l * T_TOK, (const float*)(ws + WS_BIAS1) + (size_t)l * 4 * NPROJ + 2048, NPROJ};
              pg8::gemm_phase<pg8::EpiStoreRS<0>, pg8::StaticOrder, true, true>(lds3, g, S, E); }
          else { FRESH_IDS(); phase_post(l, (bid - nbig) * 8 + wave_f, (G - nbig) * 8, lane_f); } }
        GRID_SYNC();
        { const int half = G / 2;
          if (bid < half) { pg8::Gemm g{(const bf16_t*)(ws + WS_BQN), (const bf16_t*)(ws + WS_WUQ) + (size_t)l * 512 * 256, T_TOK, 512, 256}; pg8::StaticOrder S; S.init(T_TOK, 512, half, bid);
              pg8::EpiStore<0> E{(bf16_t*)(ws + WS_QB), 384, 384};
              pg8::gemm_phase<pg8::EpiStore<0>, pg8::StaticOrder, true, true>(lds3, g, S, E); }
          else { pg8::Gemm g{(const bf16_t*)(ws + WS_BKVN), (const bf16_t*)(ws + WS_WUKV) + (size_t)l * 512 * 128, T_TOK, 512, 128}; pg8::StaticOrder S; S.init(T_TOK, 512, G - half, bid - half);
              pg8::EpiStore<0> E{(bf16_t*)(ws + WS_KVB), 512, 512};
              pg8::gemm_phase<pg8::EpiStore<0>, pg8::StaticOrder, true, true>(lds3, g, S, E); } }
        GRID_SYNC();
        { FRESH_IDS(); phase_attention((unsigned*)(ws + WS_CTL) + 64 * l, lds, tid_f, wave_f, lane_f); }
        GRID_SYNC();
        { FRESH_IDS(); phase_merge(l, gw_f, NGW, lane_f); }
        GRID_SYNC();
        { pg8::Gemm g{H, (const bf16_t*)(ws + WS_WOUT) + (size_t)l * 1024 * 1024, T_TOK, DM, DM}; pg8::StaticOrder S; S.init(T_TOK, DM, G, bid);
          pg8::EpiResidH E{xin, POUT, modl + 2048, PIN(5) + l * DM, modl + 4096, (bf16_t*)(ws + WS_H2), (float*)(ws + WS_SSQ) + (size_t)l * T_TOK};
          pg8::gemm_phase<pg8::EpiResidH, pg8::StaticOrder, true, true>(lds3, g, S, E); }
        GRID_SYNC();
        { pg8::Gemm g{(const bf16_t*)(ws + WS_H2), (const bf16_t*)(ws + WS_WFF1) + (size_t)l * DFF * 1024, T_TOK, DFF, DM}; pg8::StaticOrder S; S.init(T_TOK, DFF, G, bid);
          pg8::EpiStoreRS<2> E{(bf16_t*)(ws + WS_HID), DFF, (const float*)(ws + WS_SSQ) + (size_t)l * T_TOK, (const float*)(ws + WS_BIAS2) + (size_t)l * 4 * DFF, DFF};
          pg8::gemm_phase<pg8::EpiStoreRS<2>, pg8::StaticOrder, true, true>(lds3, g, S, E); }
        GRID_SYNC();
        { pg8::Gemm g{(const bf16_t*)(ws + WS_HID), (const bf16_t*)(ws + WS_WFF2) + (size_t)l * 1024 * DFF, T_TOK, DM, DFF}; pg8::StaticOrder S; S.init(T_TOK, DM, G, bid);
          pg8::EpiResidH E{POUT, POUT, modl + 5120, PIN(4) + DM, mod + (size_t)4 * NMOD + 1024, (l == 0) ? H : (bf16_t*)nullptr, (float*)(ws + WS_SSQ1) + T_TOK};
          pg8::gemm_phase<pg8::EpiResidH, pg8::StaticOrder, true, true>(lds3, g, S, E); }
        GRID_SYNC();
    }
    { FRESH_IDS(); phase_final_norm(POUT, PIN(17), gw_f, NGW, lane_f); }
}

extern "C" void kernel_launch(void* const* d_in, const int* in_sizes, int n_in, void* d_out, int out_size, void* d_ws, size_t ws_size, hipStream_t stream) {
    static int grid_blocks = 0;
    if (grid_blocks == 0) {
        if (n_in != 18 || out_size != T_TOK * DM || ws_size < WS_END) { fprintf(stderr, "kernel_launch: unexpected shapes (n_in %d out %d ws %zu)\n", n_in, out_size, ws_size); grid_blocks = -1; return; }
        int dev = 0, cus = 0, per_cu = 0;
        (void)hipGetDevice(&dev);
        (void)hipDeviceGetAttribute(&cus, hipDeviceAttributeMultiprocessorCount, dev);
        if (hipFuncSetAttribute((const void*)mega_fwd, hipFuncAttributeMaxDynamicSharedMemorySize, LDS_BYTES) != hipSuccess) { fprintf(stderr, "kernel_launch: hipFuncSetAttribute failed\n"); grid_blocks = -1; return; }
        if (hipOccupancyMaxActiveBlocksPerMultiprocessor(&per_cu, (const void*)mega_fwd, 512, LDS_BYTES) != hipSuccess || per_cu < 1) { fprintf(stderr, "kernel_launch: the occupancy query reports %d resident workgroups per CU for this kernel (512 threads, %d B LDS); nothing launched\n", per_cu, LDS_BYTES); (void)hipGetLastError(); grid_blocks = -1; return; }
        grid_blocks = cus * 1;
        if (per_cu < 1) grid_blocks = -1;
    }
    if (grid_blocks < 0) return;
    (void)hipMemsetAsync((char*)d_ws + WS_CTL, 0, 32768, stream);
    Params p{};
    for (int i = 0; i < 18; ++i) p.in[i] = (const float*)d_in[i];
    p.out = (float*)d_out; p.ws = (unsigned char*)d_ws;
    void* args[] = {&p};
    hipError_t e = hipLaunchCooperativeKernel((const void*)mega_fwd, dim3(grid_blocks), dim3(512), args, LDS_BYTES, stream);
    if (e != hipSuccess) fprintf(stderr, "cooperative launch failed: %s (grid %d)\n", hipGetErrorString(e), grid_blocks);
}
```

```cpp
#include <hip/hip_runtime.h>
#include <hip/hip_cooperative_groups.h>
#include <cstdio>
#include <cstdint>
namespace cg = cooperative_groups;
namespace pg8 {
#define PG8_LAS __attribute__((address_space(3)))
typedef unsigned short bf16_t;
typedef short bf16x8 __attribute__((ext_vector_type(8)));
typedef float f32x4 __attribute__((ext_vector_type(4)));
typedef unsigned u32x4 __attribute__((ext_vector_type(4)));
constexpr int BM = 256, BK = 64, HALF = 128, HTB = HALF * BK * 2  , STAGE_BYTES = 8 * HTB, NXCD = 8, WGM = 8;

__host__ __device__ __forceinline__ int lds_byte(int r, int c) { const int st = (r >> 4) * 2 + (c >> 5), rr = r & 15, cc = c & 31, ob = rr * 64 + cc * 2; return st * 1024 + (ob ^ (((ob >> 9) & 1) << 5)); }
__host__ __device__ __forceinline__ void stage_rc(int b, int& R, int& C) { const int st = b / 1024, sb = b % 1024, swz = sb ^ (((sb >> 9) & 1) << 5); R = (st >> 1) * 16 + swz / 64; C = (st & 1) * 32 + (swz % 64) / 2; }
__host__ __device__ __forceinline__ int perm32(int rho) { const int n = rho >> 4, i = rho & 15; return 8 * (i >> 2) + 4 * n + (i & 3); }

struct Unit { int pm, pn; };
struct Gemm { const bf16_t* A; const bf16_t* Bt; int M, N, K; };

struct StaticOrder {
    int nM, nN, nwg, G, c;
    __host__ __device__ void init(int M, int N, int G_, int c_) { nM = M / BM; nN = N / BM; nwg = nM * nN; G = G_; c = c_; }
    __host__ __device__ bool next(int i, Unit& u) const {
        const long L = (long)i * G + c; if (L >= nwg) return false;
        int wgid = (int)L; { const int q = nwg / NXCD, r = nwg % NXCD, xcd = wgid % NXCD, off = wgid / NXCD; wgid = (xcd < r ? xcd * (q + 1) : r * (q + 1) + (xcd - r) * q) + off; }
        const int nig = WGM * nN, gid = wgid / nig, fm = gid * WGM, gsz = (nM - fm) < WGM ? (nM - fm) : WGM;
        u.pm = fm + ((wgid % nig) % gsz); u.pn = (wgid % nig) / gsz; return true;
    }
    __device__ __forceinline__ void a_ready(const Unit&) const {}
    __device__ __forceinline__ void done(const Unit&) const {}
};

__device__ __forceinline__ unsigned cvt_pk_bf16(float lo, float hi) { unsigned r; asm volatile("v_cvt_pk_bf16_f32 %0, %1, %2" : "=v"(r) : "v"(lo), "v"(hi)); return r; }
typedef float f32x2 __attribute__((ext_vector_type(2)));

template <int ACT> struct EpiStore {
    static constexpr bool PERM = true, AFTER_DRAIN = false;
    bf16_t* O; int ldc; int nvalid;
    __device__ __forceinline__ void operator()(const f32x4 (&acc)[2][2][4][2], const Unit& u, int wr, int wc, int fr_, int fq_) const {
        int ln = __builtin_amdgcn_mbcnt_hi(~0u, __builtin_amdgcn_mbcnt_lo(~0u, 0u)); asm volatile("" : "+v"(ln)); const int fr = ln & 15, fq = ln >> 4;
        const int row0 = u.pm * BM + wr * 64 + fr; const int col0 = u.pn * BM + wc * 32 + 8 * fq;
#pragma unroll
        for (int ai = 0; ai < 2; ++ai)
#pragma unroll
            for (int m = 0; m < 4; ++m) { bf16_t* rowp = O + (size_t)(row0 + ai * HALF + m * 16) * ldc;
#pragma unroll
                for (int bj = 0; bj < 2; ++bj) { const int c = col0 + bj * HALF;
                    if (c < nvalid) { f32x4 v0 = acc[ai][bj][m][0], v1 = acc[ai][bj][m][1];
                        if (ACT == 2) { v0 = __builtin_elementwise_max(v0, (f32x4){0.f, 0.f, 0.f, 0.f}); v1 = __builtin_elementwise_max(v1, (f32x4){0.f, 0.f, 0.f, 0.f}); v0 = v0 * v0; v1 = v1 * v1; }
                        u32x4 w; w.x = cvt_pk_bf16(v0[0], v0[1]); w.y = cvt_pk_bf16(v0[2], v0[3]); w.z = cvt_pk_bf16(v1[0], v1[1]); w.w = cvt_pk_bf16(v1[2], v1[3]);
                        *(u32x4*)(rowp + c) = w; } } }
    }
};
struct EpiResid {
    static constexpr bool PERM = false, AFTER_DRAIN = false;
    const float* base; float* out; const float* gate;
    __device__ __forceinline__ void operator()(const f32x4 (&acc)[2][2][4][2], const Unit& u, int wr, int wc, int fr_, int fq_) const {
        int ln = __builtin_amdgcn_mbcnt_hi(~0u, __builtin_amdgcn_mbcnt_lo(~0u, 0u)); asm volatile("" : "+v"(ln)); const int fr = ln & 15, fq = ln >> 4;
        const float* g = gate + (size_t)((u.pm * BM) >> 12) * 6144;
        const int col0 = u.pn * BM + wc * 32 + 4 * fq;
#pragma unroll
        for (int bj = 0; bj < 2; ++bj)
#pragma unroll
            for (int n = 0; n < 2; ++n) { const int col = col0 + bj * HALF + n * 16; const f32x4 gv = *(const f32x4*)(g + col);
#pragma unroll
                for (int ai = 0; ai < 2; ++ai)
#pragma unroll
                    for (int m = 0; m < 4; ++m) { const size_t off = (size_t)(u.pm * BM + ai * HALF + wr * 64 + m * 16 + fr) * 1024 + col;
                        const f32x4 b = *(const f32x4*)(base + off); *(f32x4*)(out + off) = b + gv * acc[ai][bj][m][n]; } }
    }
};
typedef unsigned u32x2v __attribute__((ext_vector_type(2)));
struct EpiResidH {
    static constexpr bool PERM = false, AFTER_DRAIN = false;
    const float* base; float* out; const float* gate; const float* nw; const float* sc; bf16_t* H2; float* ssq;
    __device__ __forceinline__ void operator()(const f32x4 (&acc)[2][2][4][2], const Unit& u, int wr, int wc, int fr_, int fq_) const {
        int ln = __builtin_amdgcn_mbcnt_hi(~0u, __builtin_amdgcn_mbcnt_lo(~0u, 0u)); asm volatile("" : "+v"(ln)); const int fr = ln & 15, fq = ln >> 4;
        const size_t boff = (size_t)((u.pm * BM) >> 12) * 6144;
        const float* g = gate + boff; const float* scb = sc + boff;
        const int col0 = u.pn * BM + wc * 32 + 4 * fq;
        f32x4 gv[2][2], cv[2][2];
#pragma unroll
        for (int bj = 0; bj < 2; ++bj)
#pragma unroll
            for (int n = 0; n < 2; ++n) { const int col = col0 + bj * HALF + n * 16; gv[bj][n] = *(const f32x4*)(g + col); cv[bj][n] = *(const f32x4*)(nw + col) * (*(const f32x4*)(scb + col) + 1.0f); }
#pragma unroll
        for (int ai = 0; ai < 2; ++ai)
#pragma unroll
            for (int m = 0; m < 4; ++m) { const int row = u.pm * BM + ai * HALF + wr * 64 + m * 16 + fr; float sq = 0.f;
#pragma unroll
                for (int bj = 0; bj < 2; ++bj)
#pragma unroll
                    for (int n = 0; n < 2; ++n) { const size_t off = (size_t)row * 1024 + col0 + bj * HALF + n * 16;
                        const f32x4 o = *(const f32x4*)(base + off) + gv[bj][n] * acc[ai][bj][m][n]; *(f32x4*)(out + off) = o;
                        sq += (o.x * o.x + o.y * o.y) + (o.z * o.z + o.w * o.w);
                        if (H2) { const f32x4 h = o * cv[bj][n]; u32x2v w; w.x = cvt_pk_bf16(h.x, h.y); w.y = cvt_pk_bf16(h.z, h.w); *(u32x2v*)(H2 + off) = w; } }
                { auto r = __builtin_amdgcn_permlane16_swap(__float_as_uint(sq), __float_as_uint(sq), false, false); sq = __uint_as_float(r[0]) + __uint_as_float(r[1]); }
                { auto r = __builtin_amdgcn_permlane32_swap(__float_as_uint(sq), __float_as_uint(sq), false, false); sq = __uint_as_float(r[0]) + __uint_as_float(r[1]); }
                if (H2 && fq == 0) (void)__hip_atomic_fetch_add(ssq + row, sq, __ATOMIC_RELAXED, __HIP_MEMORY_SCOPE_AGENT); }
    }
};
template <int ACT> struct EpiStoreRS {
    static constexpr bool PERM = true, AFTER_DRAIN = false;
    bf16_t* O; int ldc; const float* ssq; const float* bias; int ldb;
    __device__ __forceinline__ void operator()(const f32x4 (&acc)[2][2][4][2], const Unit& u, int wr, int wc, int fr_, int fq_) const {
        int ln = __builtin_amdgcn_mbcnt_hi(~0u, __builtin_amdgcn_mbcnt_lo(~0u, 0u)); asm volatile("" : "+v"(ln)); const int fr = ln & 15, fq = ln >> 4;
        const int row0 = u.pm * BM + wr * 64 + fr; const int col0 = u.pn * BM + wc * 32 + 8 * fq;
        const float* bb = bias + (size_t)((u.pm * BM) >> 12) * ldb + col0;
        f32x4 bv[2][2];
#pragma unroll
        for (int bj = 0; bj < 2; ++bj) { bv[bj][0] = *(const f32x4*)(bb + bj * HALF); bv[bj][1] = *(const f32x4*)(bb + bj * HALF + 4); }
#pragma unroll
        for (int ai = 0; ai < 2; ++ai)
#pragma unroll
            for (int m = 0; m < 4; ++m) { const int row = row0 + ai * HALF + m * 16; const float rs = 1.0f / sqrtf(ssq[row] * (1.0f / 1024.0f) + 1e-6f);
                bf16_t* rowp = O + (size_t)row * ldc;
#pragma unroll
                for (int bj = 0; bj < 2; ++bj) { f32x4 v0 = acc[ai][bj][m][0] * rs + bv[bj][0], v1 = acc[ai][bj][m][1] * rs + bv[bj][1];
                    if (ACT == 2) { v0 = __builtin_elementwise_max(v0, (f32x4){0.f, 0.f, 0.f, 0.f}); v1 = __builtin_elementwise_max(v1, (f32x4){0.f, 0.f, 0.f, 0.f}); v0 = v0 * v0; v1 = v1 * v1; }
                    u32x4 w; w.x = cvt_pk_bf16(v0[0], v0[1]); w.y = cvt_pk_bf16(v0[2], v0[3]); w.z = cvt_pk_bf16(v1[0], v1[1]); w.w = cvt_pk_bf16(v1[2], v1[3]);
                    *(u32x4*)(rowp + col0 + bj * HALF) = w; } }
    }
};
template <class Epi, class Sched, bool ALIGN_EPI = false, bool SP2 = false>
__device__ __forceinline__ void gemm_phase(PG8_LAS unsigned char* lds, const Gemm g, const Sched& S, const Epi& E) {
    int tid_raw = threadIdx.x; asm volatile("" : "+v"(tid_raw));
    const int tid = tid_raw, wid = __builtin_amdgcn_readfirstlane(tid >> 6), lane = tid & 63, wr = wid >> 2, wc = wid & 3, fr = lane & 15, fq = lane >> 4;
    const int K = g.K, nt = K / BK;
    unsigned voffA[2], voffB[2];
#pragma unroll
    for (int i = 0; i < 2; ++i) { int R, C; stage_rc(tid * 16 + i * 8192, R, C); const int Rb = Epi::PERM ? ((R & ~31) + perm32(R & 31)) : R;
        voffA[i] = (unsigned)(R * K + C) * 2u; voffB[i] = (unsigned)(Rb * K + C) * 2u; }
    const size_t kstep = (size_t)(BK * 2);
    const size_t hstep = (size_t)HALF * K * 2;
    const size_t tstep = 2 * hstep;
    const unsigned ldsw = (unsigned)wid * 1024u;
    const int aoff = lds_byte(wr * 64 + fr, fq * 8), boff = lds_byte(wc * 32 + fr, fq * 8);
#define PG8_SA(b, h) (((b) * 2 + (h)) * HTB)
#define PG8_SB(b, h) ((4 + (b) * 2 + (h)) * HTB)
#define PG8_STAGE(bufoff, gbase, voff) do { _Pragma("unroll") for (int _i = 0; _i < 2; ++_i) \
        __builtin_amdgcn_global_load_lds((const unsigned*)((const char*)(gbase) + (voff)[_i]), (PG8_LAS unsigned*)(lds + (bufoff) + ldsw + _i * 8192), 16, 0, 0); } while (0)
#define PG8_LDA(dst, b, h) do { _Pragma("unroll") for (int m = 0; m < 4; ++m) _Pragma("unroll") for (int k = 0; k < 2; ++k) dst[m][k] = *(const PG8_LAS bf16x8*)(lds + PG8_SA(b, h) + aoff + m * 2048 + k * 1024); } while (0)
#define PG8_LDB(dst, b, h) do { _Pragma("unroll") for (int n = 0; n < 2; ++n) _Pragma("unroll") for (int k = 0; k < 2; ++k) dst[n][k] = *(const PG8_LAS bf16x8*)(lds + PG8_SB(b, h) + boff + n * 2048 + k * 1024); } while (0)
#define PG8_MMA(ai, bj, At, Bt) do { __builtin_amdgcn_s_setprio(1); _Pragma("unroll") for (int m = 0; m < 4; ++m) _Pragma("unroll") for (int n = 0; n < 2; ++n) _Pragma("unroll") for (int k = 0; k < 2; ++k) \
        acc[ai][bj][m][n] = __builtin_amdgcn_mfma_f32_16x16x32_bf16(Bt[n][k], At[m][k], acc[ai][bj][m][n], 0, 0, 0); __builtin_amdgcn_s_setprio(0); } while (0)
#define PG8_WAIT_V(n) asm volatile("s_waitcnt vmcnt(" #n ")" ::: "memory")
#define PG8_WAIT_L(n) asm volatile("s_waitcnt lgkmcnt(" #n ")" ::: "memory")
#define PG8_BAR __builtin_amdgcn_s_barrier()
#define PG8_SCHED __builtin_amdgcn_sched_barrier(0)
    Unit cur, nxt; int ui = 0;
    if (!S.next(0, cur)) return;
    f32x4 acc[2][2][4][2];
#pragma unroll
    for (int a = 0; a < 2; ++a)
#pragma unroll
        for (int b = 0; b < 2; ++b)
#pragma unroll
            for (int m = 0; m < 4; ++m)
#pragma unroll
                for (int n = 0; n < 2; ++n) acc[a][b][m][n] = (f32x4){0.f, 0.f, 0.f, 0.f};
    bf16x8 At[4][2], B0[2][2], B1[2][2];
    const char* cA = (const char*)g.A + (size_t)cur.pm * tstep; const char* cB = (const char*)g.Bt + (size_t)cur.pn * tstep;
    S.a_ready(cur);
    if constexpr (SP2) {
        PG8_STAGE(PG8_SB(0, 0), cB, voffB); PG8_STAGE(PG8_SB(0, 1), cB + hstep, voffB); PG8_STAGE(PG8_SA(0, 0), cA, voffA); PG8_STAGE(PG8_SA(0, 1), cA + hstep, voffA);
        if (wr == 1) PG8_BAR;
        PG8_WAIT_V(2); PG8_BAR;
        PG8_STAGE(PG8_SB(1, 0), cB + kstep, voffB); PG8_STAGE(PG8_SA(1, 0), cA + kstep, voffA); PG8_STAGE(PG8_SB(1, 1), cB + hstep + kstep, voffB);
        PG8_WAIT_V(6); PG8_BAR;
    } else {
        PG8_STAGE(PG8_SB(0, 0), cB, voffB); PG8_STAGE(PG8_SA(0, 0), cA, voffA); PG8_STAGE(PG8_SB(0, 1), cB + hstep, voffB); PG8_STAGE(PG8_SA(0, 1), cA + hstep, voffA);
        if (wr == 1) PG8_BAR;
        PG8_WAIT_V(4); PG8_BAR;
        PG8_STAGE(PG8_SB(1, 0), cB + kstep, voffB); PG8_STAGE(PG8_SA(1, 0), cA + kstep, voffA); PG8_STAGE(PG8_SB(1, 1), cB + hstep + kstep, voffB);
        PG8_WAIT_V(6); PG8_BAR;
    }
    for (;;) {
        const bool has_next = S.next(ui + 1, nxt);
        const char* nA = has_next ? (const char*)g.A + (size_t)nxt.pm * tstep : cA; const char* nB = has_next ? (const char*)g.Bt + (size_t)nxt.pn * tstep : cB;
        for (int t = 0; t < nt; t += 2) {
            const bool last = (t == nt - 2);
            const char* a1 = cA + (size_t)(t + 1) * kstep;
            const char* a2 = last ? nA : cA + (size_t)(t + 2) * kstep; const char* b2 = last ? nB : cB + (size_t)(t + 2) * kstep;
            const char* a3 = a2 + kstep; const char* b3 = b2 + kstep;
            if (last && has_next) S.a_ready(nxt);
            if constexpr (SP2) {
            PG8_LDB(B0, 0, 0); PG8_LDB(B1, 0, 1); PG8_SCHED; PG8_LDA(At, 0, 0); PG8_STAGE(PG8_SA(1, 1), a1 + hstep, voffA);
            PG8_WAIT_V(8); PG8_WAIT_L(0); PG8_BAR; PG8_MMA(0, 0, At, B0); PG8_MMA(0, 1, At, B1); PG8_BAR; PG8_SCHED;
            PG8_LDA(At, 0, 1); PG8_STAGE(PG8_SB(0, 0), b2, voffB); PG8_STAGE(PG8_SB(0, 1), b2 + hstep, voffB); PG8_STAGE(PG8_SA(0, 0), a2, voffA);
            PG8_WAIT_V(8); PG8_WAIT_L(0); PG8_BAR; PG8_MMA(1, 0, At, B0); PG8_MMA(1, 1, At, B1); PG8_BAR; PG8_SCHED;
            PG8_LDB(B0, 1, 0); PG8_LDB(B1, 1, 1); PG8_SCHED; PG8_LDA(At, 1, 0); PG8_STAGE(PG8_SA(0, 1), a2 + hstep, voffA);
            PG8_WAIT_V(8); PG8_WAIT_L(0); PG8_BAR; PG8_MMA(0, 0, At, B0); PG8_MMA(0, 1, At, B1); PG8_BAR; PG8_SCHED;
            PG8_LDA(At, 1, 1); PG8_STAGE(PG8_SB(1, 0), b3, voffB); PG8_STAGE(PG8_SB(1, 1), b3 + hstep, voffB); PG8_STAGE(PG8_SA(1, 0), a3, voffA);
            PG8_WAIT_V(8); PG8_WAIT_L(0); PG8_BAR; PG8_MMA(1, 0, At, B0); PG8_MMA(1, 1, At, B1); PG8_BAR; PG8_SCHED;
            } else {
            PG8_LDB(B0, 0, 0); PG8_SCHED; PG8_LDA(At, 0, 0); PG8_STAGE(PG8_SA(1, 1), a1 + hstep, voffA);
            PG8_WAIT_L(8); PG8_BAR; PG8_WAIT_L(0); PG8_MMA(0, 0, At, B0); PG8_BAR; PG8_SCHED;
            PG8_LDB(B1, 0, 1); PG8_STAGE(PG8_SB(0, 0), b2, voffB);
            PG8_BAR; PG8_WAIT_L(0); PG8_MMA(0, 1, At, B1); PG8_BAR;
            PG8_LDA(At, 0, 1); PG8_STAGE(PG8_SA(0, 0), a2, voffA);
            PG8_BAR; PG8_WAIT_L(0); PG8_MMA(1, 0, At, B0); PG8_BAR; PG8_SCHED;
            PG8_STAGE(PG8_SB(0, 1), b2 + hstep, voffB);
            PG8_WAIT_V(6); PG8_BAR; PG8_MMA(1, 1, At, B1); PG8_BAR;
            PG8_LDB(B0, 1, 0); PG8_SCHED; PG8_LDA(At, 1, 0); PG8_STAGE(PG8_SA(0, 1), a2 + hstep, voffA);
            PG8_WAIT_L(8); PG8_BAR; PG8_WAIT_L(0); PG8_MMA(0, 0, At, B0); PG8_BAR; PG8_SCHED;
            PG8_LDB(B1, 1, 1); PG8_STAGE(PG8_SB(1, 0), b3, voffB);
            PG8_BAR; PG8_WAIT_L(0); PG8_MMA(0, 1, At, B1); PG8_BAR;
            PG8_LDA(At, 1, 1); PG8_STAGE(PG8_SA(1, 0), a3, voffA);
            PG8_BAR; PG8_WAIT_L(0); PG8_MMA(1, 0, At, B0); PG8_BAR; PG8_SCHED;
            PG8_STAGE(PG8_SB(1, 1), b3 + hstep, voffB);
            PG8_WAIT_V(6); PG8_BAR; PG8_MMA(1, 1, At, B1); PG8_BAR;
            }
        }
        if constexpr (ALIGN_EPI) { if (wr == 0) PG8_BAR; }
        if constexpr (!Epi::AFTER_DRAIN) { E(acc, cur, wr, wc, fr, fq); S.done(cur); }
        if (!has_next) break;
#pragma unroll
        for (int a = 0; a < 2; ++a)
#pragma unroll
            for (int b = 0; b < 2; ++b)
#pragma unroll
                for (int m = 0; m < 4; ++m)
#pragma unroll
                    for (int n = 0; n < 2; ++n) acc[a][b][m][n] = (f32x4){0.f, 0.f, 0.f, 0.f};
        cur = nxt; cA = nA; cB = nB; ++ui;
        if constexpr (ALIGN_EPI) { if (wr == 1) PG8_BAR; }
    }
    PG8_WAIT_V(0);
    if constexpr (!ALIGN_EPI) { if (wr == 0) PG8_BAR; }
    PG8_BAR;
    if constexpr (Epi::AFTER_DRAIN) { E.fused(acc, cur, wr, wc, fr, fq, lds, wid, lane); S.done(cur); }
#undef PG8_SA
#undef PG8_SB
#undef PG8_STAGE
#undef PG8_LDA
#undef PG8_LDB
#undef PG8_MMA
#undef PG8_WAIT_V
#undef PG8_WAIT_L
#undef PG8_BAR
#undef PG8_SCHED
}
}

#define DI __device__ __forceinline__
#define LAS __attribute__((address_space(3)))
typedef unsigned short bf16_t;
typedef float f32x4 __attribute__((ext_vector_type(4)));
typedef unsigned u32x4 __attribute__((ext_vector_type(4)));
typedef unsigned u32x2 __attribute__((ext_vector_type(2)));
constexpr int T_TOK = 16384, SEQ = 4096, DM = 1024, NPROJ = 2304, DFF = 4096, NMOD = 6144;
constexpr float EPS = 1e-6f;
constexpr float LOG2E = 1.4426950408889634f;
constexpr float QSCALE64 = 0.125f * LOG2E;
constexpr float QSCALE96 = 0.10206207261596577f * LOG2E;
constexpr int C_AQ = 0, C_AK = 384, C_AV = 512, C_BQ = 640, C_BKV = 896, C_BKR = 1024, C_CQ = 1056, C_CK = 1440, C_CV = 1824;
constexpr size_t MiB = 1u << 20;
constexpr size_t WS_CTL = 0, WS_MOD = 65536;
constexpr size_t WS_CSAX = 1 * MiB, WS_CSDIL = 2 * MiB, WS_CSMLA = 3 * MiB;
constexpr size_t WS_WIN = 4 * MiB, WS_WOUT = 13 * MiB, WS_WFF1 = 17 * MiB, WS_WFF2 = 33 * MiB, WS_WUQ = 49 * MiB, WS_WUKV = 49 * MiB + 512 * 1024;
constexpr size_t WS_H = 50 * MiB, WS_PROJ = 82 * MiB, WS_QB = 154 * MiB, WS_KVB = 166 * MiB, WS_YAB = 182 * MiB, WS_YC = 202 * MiB, WS_LSE = 238 * MiB;
constexpr size_t WS_BQN = 240 * MiB, WS_BKVN = 248 * MiB, WS_HID = 82 * MiB, WS_END = 252 * MiB;
constexpr size_t WS_SSQ = 3 * MiB + 512 * 1024, WS_BIAS2 = WS_SSQ + 131072;
constexpr size_t WS_SSQ1 = WS_BIAS2 + 131072, WS_BIAS1 = WS_SSQ1 + 131072;
constexpr size_t WS_H2 = 210 * MiB;
constexpr int LDS_BYTES = 147456;

__device__ const double INV64[32] = {1.0, 0.7498942093324559, 0.5623413251903491, 0.4216965034285822, 0.31622776601683794, 0.23713737056616552, 0.1778279410038923, 0.1333521432163324, 0.1, 0.07498942093324558, 0.05623413251903491, 0.042169650342858224, 0.03162277660168379, 0.023713737056616554, 0.01778279410038923, 0.01333521432163324, 0.01, 0.007498942093324558, 0.005623413251903491, 0.004216965034285823, 0.0031622776601683794, 0.0023713737056616554, 0.0017782794100389228, 0.001333521432163324, 0.001, 0.0007498942093324559, 0.0005623413251903491, 0.00042169650342858224, 0.00031622776601683794, 0.00023713737056616554, 0.00017782794100389227, 0.0001333521432163324};

DI float bf2f(bf16_t v) { return __uint_as_float((unsigned)v << 16); }
DI unsigned f2bf(float f) { unsigned u = __float_as_uint(f); return (u + 0x7fffu + ((u >> 16) & 1u)) >> 16; }
DI unsigned pk2(float lo, float hi) { return f2bf(lo) | (f2bf(hi) << 16); }
DI float wave_sum(float v) {
#pragma unroll
    for (int o = 1; o < 64; o <<= 1) v += __shfl_xor(v, o);
    return v;
}
DI float2 cs_of(double a) {
    const double rv = a * 0.15915494309189535; const double fr = rv - rint(rv); const float f = (float)fr;
    return make_float2(__builtin_amdgcn_cosf(f), __builtin_amdgcn_sinf(f));
}

struct Params { const float* in[18]; float* out; unsigned char* ws; };
typedef const __attribute__((address_space(4))) Params* KParams;
DI KParams kparams() { KParams k = (KParams)__builtin_amdgcn_kernarg_segment_ptr(); asm volatile("" : "+s"(k)); return k; }
#define PIN(i) (kparams()->in[i])
#define POUT (kparams()->out)
#define PWS (kparams()->ws)

DI void transpose_item(const float* W, int K, int N, bf16_t* WT, LAS float* scr, int item, int lane) {
    const int nblk = N / 32, kb = item / nblk, nb = item % nblk, k0 = 64 * kb, n0 = 32 * nb;
#pragma unroll 8
    for (int i = 0; i < 32; ++i) { const int kk = 2 * i + (lane >> 5); scr[kk * 33 + (lane & 31)] = W[(size_t)(k0 + kk) * N + n0 + (lane & 31)]; }
    asm volatile("s_waitcnt lgkmcnt(0)" ::: "memory");
    const int c = lane & 7;
#pragma unroll
    for (int j = 0; j < 4; ++j) { const int n = (lane >> 3) + 8 * j; const LAS float* s = scr + (8 * c) * 33 + n;
        u32x4 o; o.x = pk2(s[0 * 33], s[1 * 33]); o.y = pk2(s[2 * 33], s[3 * 33]); o.z = pk2(s[4 * 33], s[5 * 33]); o.w = pk2(s[6 * 33], s[7 * 33]);
        *(u32x4*)(WT + (size_t)(n0 + n) * K + k0 + 8 * c) = o; }
    asm volatile("s_waitcnt lgkmcnt(0)" ::: "memory");
}

DI void phase_prologue(unsigned char* lds, int bid, int G, int tid, int lane, int wave) {
    unsigned char* ws = PWS;
    {
        float* sil = (float*)lds;
        float* red = (float*)(lds + 16384);
        for (int i = tid; i < 4096; i += 512) { const float c = PIN(1)[i]; sil[i] = c / (1.f + __expf(-c)); }
        __syncthreads();
        float* mod = (float*)(ws + WS_MOD);
        for (int item = bid; item < 192; item += G) {
            const int l = item / 96, cgp = item % 96, col = cgp * 64 + lane;
            const float* W = PIN(2) + (size_t)l * 1024 * NMOD + col;
            float a0 = 0.f, a1 = 0.f, a2 = 0.f, a3 = 0.f;
            const int k0 = wave * 128;
#pragma unroll 8
            for (int k = k0; k < k0 + 128; ++k) { const float w = W[(size_t)k * NMOD]; a0 += sil[k] * w; a1 += sil[1024 + k] * w; a2 += sil[2048 + k] * w; a3 += sil[3072 + k] * w; }
            red[(wave * 4 + 0) * 64 + lane] = a0; red[(wave * 4 + 1) * 64 + lane] = a1; red[(wave * 4 + 2) * 64 + lane] = a2; red[(wave * 4 + 3) * 64 + lane] = a3;
            __syncthreads();
            if (wave < 4) { float s = 0.f;
#pragma unroll
                for (int w8 = 0; w8 < 8; ++w8) s += red[(w8 * 4 + wave) * 64 + lane];
                mod[(size_t)(l * 4 + wave) * NMOD + col] = s + PIN(3)[l * NMOD + col]; }
            __syncthreads();
        }
    }
    {
        LAS float* scr = (LAS float*)((LAS unsigned char*)lds + 32768 + wave * 8448);
        const int gw = bid * 8 + wave, NGW = G * 8;
        constexpr int I_IN = 16 * 69, I_OUT = 16 * 32, I_F1 = 16 * 128, I_F2 = 64 * 32, I_UQ = 4 * 12, I_UKV = 2 * 16;
        constexpr int I_L = I_IN + I_OUT + I_F1 + I_F2 + I_UQ + I_UKV;
        for (int it = gw; it < 2 * I_L; it += NGW) {
            const int l = it / I_L; int r = it % I_L;
            if (r < I_IN) { transpose_item(PIN(6) + (size_t)l * 1024 * 2208, 1024, 2208, (bf16_t*)(ws + WS_WIN) + (size_t)l * NPROJ * 1024, scr, r, lane); continue; } r -= I_IN;
            if (r < I_OUT) { transpose_item(PIN(14) + (size_t)l * 1024 * 1024, 1024, 1024, (bf16_t*)(ws + WS_WOUT) + (size_t)l * 1024 * 1024, scr, r, lane); continue; } r -= I_OUT;
            if (r < I_F1) { transpose_item(PIN(15) + (size_t)l * 1024 * 4096, 1024, 4096, (bf16_t*)(ws + WS_WFF1) + (size_t)l * 4096 * 1024, scr, r, lane); continue; } r -= I_F1;
            if (r < I_F2) { transpose_item(PIN(16) + (size_t)l * 4096 * 1024, 4096, 1024, (bf16_t*)(ws + WS_WFF2) + (size_t)l * 1024 * 4096, scr, r, lane); continue; } r -= I_F2;
            if (r < I_UQ) { transpose_item(PIN(11) + (size_t)l * 256 * 384, 256, 384, (bf16_t*)(ws + WS_WUQ) + (size_t)l * 512 * 256, scr, r, lane); continue; } r -= I_UQ;
            transpose_item(PIN(12) + (size_t)l * 128 * 512, 128, 512, (bf16_t*)(ws + WS_WUKV) + (size_t)l * 512 * 128, scr, r, lane);
        }
        const int gt = bid * 512 + tid, NT = G * 512;
        const u32x4 z = {0u, 0u, 0u, 0u};
        for (int i = gt; i < 2 * 96 * 128; i += NT) { const int l = i / (96 * 128), r = i % (96 * 128); *(u32x4*)((bf16_t*)(ws + WS_WIN) + (size_t)l * NPROJ * 1024 + (size_t)2208 * 1024 + (size_t)r * 8) = z; }
        for (int i = gt; i < 2 * 128 * 32; i += NT) { const int l = i / (128 * 32), r = i % (128 * 32); *(u32x4*)((bf16_t*)(ws + WS_WUQ) + (size_t)l * 512 * 256 + (size_t)384 * 256 + (size_t)r * 8) = z; }
        { float* ssq = (float*)(ws + WS_SSQ); for (int i = gt; i < 2 * T_TOK; i += NT) ssq[i] = 0.f; }
        { float* ssq = (float*)(ws + WS_SSQ1); for (int i = gt; i < 2 * T_TOK; i += NT) ssq[i] = 0.f; }
        float2* csax = (float2*)(ws + WS_CSAX); float2* csdil = (float2*)(ws + WS_CSDIL); float2* csmla = (float2*)(ws + WS_CSMLA);
        for (int i = gt; i < SEQ * 32; i += NT) {
            const int t = i >> 5, e = i & 31;
            csdil[i] = cs_of((double)t * INV64[e]);
            const int pos = (e < 16) ? (t >> 6) : (t & 63);
            csax[i] = cs_of((double)pos * INV64[2 * (e & 15)]);
            if (e < 16) csmla[t * 16 + e] = cs_of((double)t * INV64[2 * e]);
        }
    }
}

DI void vecmat4(const float* vec, int vstride, const float* W, int N, int nitems, float* out, int ostride, unsigned char* lds, int bid, int G, int tid, int lane, int wave) {
    float* sv = (float*)lds; float* red = (float*)(lds + 16384);
    for (int i = tid; i < 4096; i += 512) sv[i] = vec[(size_t)(i >> 10) * vstride + (i & 1023)];
    __syncthreads();
    for (int item = bid; item < nitems; item += G) {
        const int col = item * 64 + lane; const bool cin = (col < N);
        const float* Wc = W + (cin ? col : 0);
        float a0 = 0.f, a1 = 0.f, a2 = 0.f, a3 = 0.f;
        const int k0 = wave * 128;
#pragma unroll 8
        for (int k = k0; k < k0 + 128; ++k) { const float w = cin ? Wc[(size_t)k * N] : 0.f; a0 += sv[k] * w; a1 += sv[1024 + k] * w; a2 += sv[2048 + k] * w; a3 += sv[3072 + k] * w; }
        red[(wave * 4 + 0) * 64 + lane] = a0; red[(wave * 4 + 1) * 64 + lane] = a1; red[(wave * 4 + 2) * 64 + lane] = a2; red[(wave * 4 + 3) * 64 + lane] = a3;
        __syncthreads();
        if (wave < 4) { float t = 0.f;
#pragma unroll
            for (int w8 = 0; w8 < 8; ++w8) t += red[(w8 * 4 + wave) * 64 + lane];
            out[(size_t)wave * ostride + col] = t; }
        __syncthreads();
    }
}
DI void phase_norm_mod(const float* xin, const float* nw, const float* modl, int sh_off, int sc_off, bf16_t* H, int gw, int NGW, int lane) {
    for (int row = gw; row < T_TOK; row += NGW) {
        const f32x4* xr = (const f32x4*)(xin + (size_t)row * DM) + lane;
        f32x4 v[4]; float ss = 0.f;
#pragma unroll
        for (int j = 0; j < 4; ++j) { v[j] = xr[64 * j]; ss += (v[j].x * v[j].x + v[j].y * v[j].y) + (v[j].z * v[j].z + v[j].w * v[j].w); }
        const float rs = 1.0f / sqrtf(wave_sum(ss) * (1.f / DM) + EPS);
        const float* mb = modl + (size_t)(row >> 12) * NMOD;
        unsigned long long* o8 = (unsigned long long*)(H + (size_t)row * DM) + lane;
#pragma unroll
        for (int j = 0; j < 4; ++j) { const int col = 4 * (64 * j + lane);
            const f32x4 w = *(const f32x4*)(nw + col), s1 = *(const f32x4*)(mb + sc_off + col), s0 = *(const f32x4*)(mb + sh_off + col);
            const f32x4 y = (v[j] * rs * w) * (s1 + 1.0f) + s0;
            o8[64 * j] = (unsigned long long)pk2(y.x, y.y) | ((unsigned long long)pk2(y.z, y.w) << 32); }
    }
}
DI void phase_prenorm(const float* xin, const float* nw, const float* modl, int sc_off, bf16_t* H, float* ssq, int gw, int NGW, int lane) {
    for (int row = gw; row < T_TOK; row += NGW) {
        const f32x4* xr = (const f32x4*)(xin + (size_t)row * DM) + lane;
        f32x4 v[4]; float ss = 0.f;
#pragma unroll
        for (int j = 0; j < 4; ++j) { v[j] = xr[64 * j]; ss += (v[j].x * v[j].x + v[j].y * v[j].y) + (v[j].z * v[j].z + v[j].w * v[j].w); }
        ss = wave_sum(ss);
        if (lane == 0) ssq[row] = ss;
        const float* mb = modl + (size_t)(row >> 12) * NMOD;
        unsigned long long* o8 = (unsigned long long*)(H + (size_t)row * DM) + lane;
#pragma unroll
        for (int j = 0; j < 4; ++j) { const int col = 4 * (64 * j + lane);
            const f32x4 w = *(const f32x4*)(nw + col), s1 = *(const f32x4*)(mb + sc_off + col);
            const f32x4 y = (v[j] * w) * (s1 + 1.0f);
            o8[64 * j] = (unsigned long long)pk2(y.x, y.y) | ((unsigned long long)pk2(y.z, y.w) << 32); }
    }
}
DI void phase_final_norm(float* xio, const float* nw, int gw, int NGW, int lane) {
    for (int row = gw; row < T_TOK; row += NGW) {
        f32x4* xr = (f32x4*)(xio + (size_t)row * DM) + lane;
        f32x4 v[4]; float ss = 0.f;
#pragma unroll
        for (int j = 0; j < 4; ++j) { v[j] = xr[64 * j]; ss += (v[j].x * v[j].x + v[j].y * v[j].y) + (v[j].z * v[j].z + v[j].w * v[j].w); }
        const float rs = 1.0f / sqrtf(wave_sum(ss) * (1.f / DM) + EPS);
#pragma unroll
        for (int j = 0; j < 4; ++j) { const f32x4 w = *(const f32x4*)(nw + 4 * (64 * j + lane)); xr[64 * j] = v[j] * rs * w; }
    }
}
typedef short bfx8 __attribute__((ext_vector_type(8)));
DI void ld8f(const bf16_t* p, float (&x)[8]) { const bfx8 v = *(const bfx8*)p;
#pragma unroll
    for (int e = 0; e < 8; ++e) x[e] = bf2f((bf16_t)v[e]); }
DI void st8f(bf16_t* p, const float (&x)[8]) { u32x4 w; w.x = pk2(x[0], x[1]); w.y = pk2(x[2], x[3]); w.z = pk2(x[4], x[5]); w.w = pk2(x[6], x[7]); *(u32x4*)p = w; }
DI void ldcs8(const float2* t, float (&c)[8], float (&s)[8]) {
#pragma unroll
    for (int q = 0; q < 4; ++q) { const f32x4 v = *((const f32x4*)t + q); c[2 * q] = v.x; s[2 * q] = v.y; c[2 * q + 1] = v.z; s[2 * q + 1] = v.w; } }
template <int XM> DI void rope8(float (&x)[8], const float (&c)[8], const float (&s)[8], bool lo) {
#pragma unroll
    for (int e = 0; e < 8; ++e) { const float pr = __shfl_xor(x[e], XM); x[e] = lo ? (x[e] * c[e] - pr * s[e]) : (pr * s[e] + x[e] * c[e]); } }
DI void phase_post(int l, int gw, int NGW, int lane) {
    unsigned char* ws = PWS;
    bf16_t* proj = (bf16_t*)(ws + WS_PROJ); bf16_t* bqn = (bf16_t*)(ws + WS_BQN); bf16_t* bkvn = (bf16_t*)(ws + WS_BKVN);
    const float2* csax = (const float2*)(ws + WS_CSAX); const float2* csdil = (const float2*)(ws + WS_CSDIL); const float2* csmla = (const float2*)(ws + WS_CSMLA);
    const int j8 = lane & 7;
    float g1[8], g4[8];
    { const float* gp = (lane < 48) ? (PIN(7) + l * 64 + 8 * j8) : (PIN(8) + l * 64 + 8 * j8);
      const float* g4p = (lane < 32) ? (PIN(9) + l * 256 + 8 * lane) : (PIN(10) + l * 128 + 8 * (lane & 15));
#pragma unroll
      for (int e = 0; e < 8; ++e) { g1[e] = gp[e]; g4[e] = g4p[e]; } }
    const float sc1 = (lane < 48) ? QSCALE64 : 1.0f;
    const bool lo = (j8 < 4);
    for (int row = gw; row < T_TOK; row += NGW) {
        const int t = row & (SEQ - 1);
        bf16_t* pr = proj + (size_t)row * NPROJ;
        float x1[8], x2[8], x3[8], x4[8], c[8], s[8];
        ld8f(pr + 8 * lane, x1);
        if (lane < 48) { ld8f(pr + C_CQ + 8 * lane, x2); ld8f(pr + C_CK + 8 * lane, x3); }
        else {
#pragma unroll
            for (int e = 0; e < 8; ++e) { x2[e] = 0.f; x3[e] = 0.f; } }
        const bf16_t* p4 = (lane < 32) ? (pr + C_BQ + 8 * lane) : (lane < 48) ? (pr + C_BKV + 8 * (lane - 32)) : (pr + C_BKR + 8 * (lane & 3));
        ld8f(p4, x4);
        { float ss = 0.f;
#pragma unroll
          for (int e = 0; e < 8; ++e) ss += x1[e] * x1[e];
          ss += __shfl_xor(ss, 1); ss += __shfl_xor(ss, 2); ss += __shfl_xor(ss, 4);
          const float rs = 1.0f / sqrtf(ss * (1.f / 64.f) + EPS);
#pragma unroll
          for (int e = 0; e < 8; ++e) x1[e] = x1[e] * rs * g1[e];
          ldcs8(csax + t * 32 + 8 * (j8 & 3), c, s);
          rope8<4>(x1, c, s, lo);
#pragma unroll
          for (int e = 0; e < 8; ++e) x1[e] *= sc1;
          st8f(pr + 8 * lane, x1); }
        { ldcs8(csdil + t * 32 + 8 * (j8 & 3), c, s);
          rope8<4>(x2, c, s, lo); rope8<4>(x3, c, s, lo);
#pragma unroll
          for (int e = 0; e < 8; ++e) x2[e] *= QSCALE64;
          if (lane < 48) { st8f(pr + C_CQ + 8 * lane, x2); st8f(pr + C_CK + 8 * lane, x3); } }
        { float ss = 0.f;
          if (lane < 48) {
#pragma unroll
              for (int e = 0; e < 8; ++e) ss += x4[e] * x4[e]; }
          ss += __shfl_xor(ss, 1); ss += __shfl_xor(ss, 2); ss += __shfl_xor(ss, 4); ss += __shfl_xor(ss, 8); ss += __shfl_xor(ss, 16);
          const float rs = 1.0f / sqrtf(ss * ((lane < 32) ? (1.f / 256.f) : (1.f / 128.f)) + EPS);
          float y[8];
#pragma unroll
          for (int e = 0; e < 8; ++e) y[e] = x4[e] * rs * g4[e];
          ldcs8(csmla + t * 16 + 8 * (lane & 1), c, s);
          rope8<2>(x4, c, s, (lane & 2) == 0);
          if (lane < 32) st8f(bqn + (size_t)row * 256 + 8 * lane, y);
          else if (lane < 48) st8f(bkvn + (size_t)row * 128 + 8 * (lane - 32), y);
          else if (lane < 52) st8f(pr + C_BKR + 8 * (lane & 3), x4); }
    }
}
DI void phase_merge(int l, int gw, int NGW, int lane) {
    unsigned char* ws = PWS;
    const bf16_t* yab = (const bf16_t*)(ws + WS_YAB); const bf16_t* yc = (const bf16_t*)(ws + WS_YC); const float* lse = (const float*)(ws + WS_LSE);
    bf16_t* H = (bf16_t*)(ws + WS_H);
    const float* gain = PIN(13) + l * 1024;
    const bool inA = (lane < 48), inB = (lane < 32);
    float gA[8], gB[8], gC[8];
#pragma unroll
    for (int e = 0; e < 8; ++e) { gA[e] = inA ? gain[8 * lane + e] : 0.f; gB[e] = inB ? gain[384 + 8 * lane + e] : 0.f; gC[e] = inA ? gain[640 + 8 * lane + e] : 0.f; }
    const int h = (lane >> 3) < 6 ? (lane >> 3) : 0;
    for (int row = gw; row < T_TOK; row += NGW) {
        bf16_t* hr = H + (size_t)row * DM;
        float a[8], b[8], x[8];
#pragma unroll
        for (int e = 0; e < 8; ++e) { a[e] = 0.f; b[e] = 0.f; x[e] = 0.f; }
        if (inA) ld8f(yab + (size_t)row * 640 + 8 * lane, a);
        if (inB) ld8f(yab + (size_t)row * 640 + 384 + 8 * lane, b);
        if (inA) {
            float c0[8], c1[8], c2[8];
            ld8f(yc + (size_t)row * 384 + 8 * lane, c0); ld8f(yc + (size_t)(T_TOK + row) * 384 + 8 * lane, c1); ld8f(yc + (size_t)(2 * T_TOK + row) * 384 + 8 * lane, c2);
            const float l0 = lse[(size_t)row * 6 + h], l1 = lse[(size_t)(T_TOK + row) * 6 + h], l2 = lse[(size_t)(2 * T_TOK + row) * 6 + h];
            const float mx = fmaxf(l0, fmaxf(l1, l2));
            const float w0 = __builtin_amdgcn_exp2f(l0 - mx), w1 = __builtin_amdgcn_exp2f(l1 - mx), w2 = __builtin_amdgcn_exp2f(l2 - mx);
            const float inv = 1.0f / (w0 + w1 + w2);
#pragma unroll
            for (int e = 0; e < 8; ++e) x[e] = (w0 * c0[e] + w1 * c1[e] + w2 * c2[e]) * inv;
        }
        float sa = 0.f, sb = 0.f, sc = 0.f;
#pragma unroll
        for (int e = 0; e < 8; ++e) { sa += a[e] * a[e]; sb += b[e] * b[e]; sc += x[e] * x[e]; }
        const float ra = 1.0f / sqrtf(wave_sum(sa) * (1.f / 384.f) + EPS), rb = 1.0f / sqrtf(wave_sum(sb) * (1.f / 256.f) + EPS), rc = 1.0f / sqrtf(wave_sum(sc) * (1.f / 384.f) + EPS);
#pragma unroll
        for (int e = 0; e < 8; ++e) { a[e] *= ra * gA[e]; b[e] *= rb * gB[e]; x[e] *= rc * gC[e]; }
        if (inA) { st8f(hr + 8 * lane, a); st8f(hr + 640 + 8 * lane, x); }
        if (inB) st8f(hr + 384 + 8 * lane, b);
    }
}

namespace att {
typedef short bf16x8 __attribute__((ext_vector_type(8)));
typedef short s16x4 __attribute__((ext_vector_type(4)));
typedef float f32x16 __attribute__((ext_vector_type(16)));
#define SBAR() __builtin_amdgcn_sched_barrier(0)
constexpr int KBUF = 13312, VBUF = 8192, OFF_V = 4 * KBUF, OFF_WS = OFF_V + 4 * VBUF, OFF_Q = OFF_WS + 8 * 256;
constexpr float THR2 = 11.5f;
DI int crow(int r, int hi) { return (r & 3) + 8 * (r >> 2) + 4 * hi; }
DI unsigned cvtpk(float lo, float hi) { unsigned r; asm volatile("v_cvt_pk_bf16_f32 %0, %1, %2" : "=v"(r) : "v"(lo), "v"(hi)); return r; }
DI int v_st(int k, int c) { return ((k >> 3) * 2 + (c >> 5)) * 512 + ((k & 7) * 32 + (c & 31)) * 2; }
DI int v_rd_base(int lane) { return ((lane & 3) << 3) | (((lane >> 2) & 3) << 6) | (((lane >> 4) & 1) << 5) | (((lane >> 5) & 1) << 8); }
template <int OFF> DI s16x4 tr_read(int vb) { s16x4 r; asm volatile("ds_read_b64_tr_b16 %0, %1 offset:%2" : "=&v"(r) : "v"(vb), "i"(OFF) : "memory"); return r; }
template <int D0> DI void pv_one(f32x16& od, int vb, bf16x8 pa0, bf16x8 pa1, bf16x8 pa2, bf16x8 pa3) {
    const s16x4 l0 = tr_read<D0 * 512 + 0>(vb), h0 = tr_read<D0 * 512 + 1024>(vb), l1 = tr_read<D0 * 512 + 2048>(vb), h1 = tr_read<D0 * 512 + 3072>(vb);
    const s16x4 l2 = tr_read<D0 * 512 + 4096>(vb), h2 = tr_read<D0 * 512 + 5120>(vb), l3 = tr_read<D0 * 512 + 6144>(vb), h3 = tr_read<D0 * 512 + 7168>(vb);
    asm volatile("s_waitcnt lgkmcnt(0)" ::: "memory"); SBAR();
#define PK(L, H) (bf16x8){L[0], L[1], L[2], L[3], H[0], H[1], H[2], H[3]}
    od = __builtin_amdgcn_mfma_f32_32x32x16_bf16(pa0, PK(l0, h0), od, 0, 0, 0);
    od = __builtin_amdgcn_mfma_f32_32x32x16_bf16(pa1, PK(l1, h1), od, 0, 0, 0);
    od = __builtin_amdgcn_mfma_f32_32x32x16_bf16(pa2, PK(l2, h2), od, 0, 0, 0);
    od = __builtin_amdgcn_mfma_f32_32x32x16_bf16(pa3, PK(l3, h3), od, 0, 0, 0);
#undef PK
}
struct Desc {
    const bf16_t* q; long ldq;
    const bf16_t* k; long ldk;
    const bf16_t* k2; long ldk2;
    const bf16_t* v; long ldv;
    bf16_t* o; long ldo;
    float* lse; long ldlse;
    const float2* qcs;
    int kt0, kt1, q0;
    unsigned* counter;
};

template <int DQ, bool BAND>
DI int attn_unit(const Desc& u, unsigned char* lds, int tid, int wid, int lane) {
    constexpr int NK = DQ / 16, KROW = DQ * 2 + 16;
    const int r32 = lane & 31, hi = lane >> 5;
    char* K_lds = (char*)lds; char* V_lds = (char*)lds + OFF_V;
    float* wsf = (float*)(lds + OFF_WS) + wid * 64; float* li_l = wsf; float* al_l = wsf + 32;
    const int skey = tid >> 3, sc = tid & 7;
    int k1key = 0, k1c = 0; const bool k1on = (DQ == 96) && (tid < 256);
    int k0key = skey, k0c = sc;
    if constexpr (DQ == 96) { k0key = tid / 12; k0c = tid % 12; const int i1 = tid + 512; k1key = i1 / 12; k1c = i1 % 12; }
    const int vdst = v_st(skey, sc * 8);
    const int vb0 = (int)(unsigned)(size_t)V_lds + v_rd_base(lane);
    bf16x8 kreg0A, kreg1A, vregA, kreg0B, kreg1B, vregB;
    const bool k0two = (DQ == 96) && (k0c >= 8), k1two = (DQ == 96) && (k1c >= 8);
    const bf16_t* kp0 = k0two ? u.k2 + (long)k0key * u.ldk2 + (k0c - 8) * 8 : u.k + (long)k0key * u.ldk + k0c * 8;
    const bf16_t* kp1 = k1two ? u.k2 + (long)k1key * u.ldk2 + (k1c - 8) * 8 : u.k + (long)k1key * u.ldk + k1c * 8;
    const long ks0 = 64 * (k0two ? u.ldk2 : u.ldk), ks1 = 64 * (k1two ? u.ldk2 : u.ldk);
    const bf16_t* vp = u.v + (long)skey * u.ldv + sc * 8; const long vs = 64 * u.ldv;
#define A_LOAD(S, kt) do { const long kt_ = (long)(kt); kreg0##S = *(const bf16x8*)(kp0 + kt_ * ks0); \
        if constexpr (DQ == 96) { if (k1on) kreg1##S = *(const bf16x8*)(kp1 + kt_ * ks1); } \
        vreg##S = *(const bf16x8*)(vp + kt_ * vs); } while (0)
#define A_WRITE(S, b) do { *(bf16x8*)(K_lds + (b) * KBUF + k0key * KROW + k0c * 16) = kreg0##S; \
        if constexpr (DQ == 96) { if (k1on) *(bf16x8*)(K_lds + (b) * KBUF + k1key * KROW + k1c * 16) = kreg1##S; } \
        *(bf16x8*)(V_lds + (b) * VBUF + vdst) = vreg##S; } while (0)
    float m_reg = 0.f, l_reg = 0.f;
    f32x16 o0, o1, negm;
#pragma unroll
    for (int r = 0; r < 16; ++r) { o0[r] = 0.f; o1[r] = 0.f; negm[r] = 0.f; }
    const int qrow = u.q0 + wid * 32 + r32;
    const int qmin = u.q0 + wid * 32;
    A_LOAD(A, u.kt0); if (u.kt0 + 1 < u.kt1) A_LOAD(B, u.kt0 + 1);
    bf16x8 qr[NK];
    { const bf16_t* Qw = u.q + (long)(wid * 32 + r32) * u.ldq + hi * 8;
#pragma unroll
      for (int d0 = 0; d0 < NK; ++d0) qr[d0] = *(const bf16x8*)(Qw + d0 * 16);
      if constexpr (DQ == 96) {
          const float2* cs = u.qcs + (long)(wid * 32 + r32) * 16 + hi * 8;
#pragma unroll
          for (int d0 = 0; d0 < 4; ++d0) { bf16x8 t = qr[d0];
#pragma unroll
              for (int j = 0; j < 8; ++j) t[j] = (short)f2bf(bf2f((bf16_t)t[j]) * QSCALE96);
              qr[d0] = t; }
          bf16x8 a = qr[4], b = qr[5];
#pragma unroll
          for (int j = 0; j < 8; ++j) { const float2 c = cs[j]; const float x1 = bf2f((bf16_t)a[j]), x2 = bf2f((bf16_t)b[j]);
              a[j] = (short)f2bf((x1 * c.x - x2 * c.y) * QSCALE96); b[j] = (short)f2bf((x1 * c.y + x2 * c.x) * QSCALE96); }
          qr[4] = a; qr[5] = b;
      } }
    A_WRITE(A, 0); if (u.kt0 + 1 < u.kt1) A_WRITE(B, 1);
    __syncthreads();
    int un_next = 0;
    if (tid == 0) un_next = (int)__hip_atomic_fetch_add(u.counter, 1u, __ATOMIC_RELAXED, __HIP_MEMORY_SCOPE_AGENT);
    int sb = 0;
    for (int kt0_ = u.kt0; kt0_ < u.kt1; kt0_ += 2) {
      const bool n1 = (kt0_ + 2 < u.kt1), n2 = (kt0_ + 3 < u.kt1);
      if (n1) A_LOAD(A, kt0_ + 2);
      if (n2) A_LOAD(B, kt0_ + 3);
#pragma unroll
      for (int sub = 0; sub < 2; ++sub) {
        const int kt = kt0_ + sub, buf = sb + sub;
        if (kt >= u.kt1) break;
        bool active = true;
        if constexpr (BAND) active = !((kt * 64 + 63 < qmin - 64) || (kt * 64 > qmin + 31 + 64));
        if (active) {
            f32x16 p0, p1;
            const char* Kb = K_lds + buf * KBUF;
#pragma unroll
            for (int d0 = 0; d0 < NK; ++d0) { const int cb = (d0 * 16 + hi * 8) * 2;
                const bf16x8 b0 = *(const bf16x8*)(Kb + r32 * KROW + cb);
                const bf16x8 b1 = *(const bf16x8*)(Kb + (32 + r32) * KROW + cb);
                if (d0 == 0) { p0 = __builtin_amdgcn_mfma_f32_32x32x16_bf16(b0, qr[0], negm, 0, 0, 0); p1 = __builtin_amdgcn_mfma_f32_32x32x16_bf16(b1, qr[0], negm, 0, 0, 0); }
                else { p0 = __builtin_amdgcn_mfma_f32_32x32x16_bf16(b0, qr[d0], p0, 0, 0, 0); p1 = __builtin_amdgcn_mfma_f32_32x32x16_bf16(b1, qr[d0], p1, 0, 0, 0); } }
            if constexpr (BAND) {
                const int kb = kt * 64 + 4 * hi - qrow;
#pragma unroll
                for (int r = 0; r < 16; ++r) { const int dk = kb + (r & 3) + 8 * (r >> 2);
                    if (dk < -64 || dk > 64) p0[r] = -INFINITY;
                    if (dk + 32 < -64 || dk + 32 > 64) p1[r] = -INFINITY; }
            }
            float pmax = p0[0];
#pragma unroll
            for (int r = 1; r < 16; ++r) pmax = fmaxf(pmax, p0[r]);
#pragma unroll
            for (int r = 0; r < 16; ++r) pmax = fmaxf(pmax, p1[r]);
            pmax = fmaxf(pmax, __shfl_xor(pmax, 32));
            float alpha = 1.f;
            const bool first = (kt == u.kt0);
            if (first || !__all(pmax <= THR2)) {
                const float d = first ? pmax : fmaxf(pmax, 0.f);
                alpha = first ? 1.f : __builtin_amdgcn_exp2f(-d); m_reg += d;
#pragma unroll
                for (int r = 0; r < 16; ++r) { p0[r] -= d; p1[r] -= d; negm[r] = -m_reg; }
            }
            float ps = 0.f;
#pragma unroll
            for (int r = 0; r < 16; ++r) { p0[r] = __builtin_amdgcn_exp2f(p0[r]); p1[r] = __builtin_amdgcn_exp2f(p1[r]); ps += p0[r] + p1[r]; }
            ps += __shfl_xor(ps, 32);
            l_reg = l_reg * alpha + ps;
            if (__any(alpha < 1.f)) {
                if (hi == 0) al_l[r32] = alpha;
                asm volatile("s_waitcnt lgkmcnt(0)" ::: "memory");
#pragma unroll
                for (int r = 0; r < 16; ++r) { const float a = al_l[crow(r, hi)]; o0[r] *= a; o1[r] *= a; }
            }
            bf16x8 pa0, pa1, pa2, pa3;
#define PK4(P, BASE, OUT) do { u32x4 w = {cvtpk(P[BASE + 0], P[BASE + 1]), cvtpk(P[BASE + 2], P[BASE + 3]), cvtpk(P[BASE + 4], P[BASE + 5]), cvtpk(P[BASE + 6], P[BASE + 7])}; \
    OUT = *reinterpret_cast<bf16x8*>(&w); } while (0)
            PK4(p0, 0, pa0); PK4(p0, 8, pa1); PK4(p1, 0, pa2); PK4(p1, 8, pa3);
#undef PK4
            const int vb = vb0 + buf * VBUF;
            pv_one<0>(o0, vb, pa0, pa1, pa2, pa3);
            pv_one<1>(o1, vb, pa0, pa1, pa2, pa3);
        }
      }
      if (n1) A_WRITE(A, sb ^ 2);
      if (n2) A_WRITE(B, (sb ^ 2) + 1);
      __syncthreads();
      sb ^= 2;
    }
#undef A_LOAD
#undef A_WRITE
    if (hi == 0) li_l[r32] = l_reg;
    asm volatile("s_waitcnt lgkmcnt(0)" ::: "memory");
    bf16_t* Ow = u.o + (long)(wid * 32) * u.ldo;
#pragma unroll
    for (int r = 0; r < 16; ++r) { const int orow = crow(r, hi); const float rl = 1.0f / li_l[orow];
        Ow[(long)orow * u.ldo + r32] = (bf16_t)f2bf(o0[r] * rl);
        Ow[(long)orow * u.ldo + 32 + r32] = (bf16_t)f2bf(o1[r] * rl); }
    if constexpr (BAND) { if (hi == 0) u.lse[(long)(wid * 32 + r32) * u.ldlse] = m_reg + __builtin_amdgcn_logf(l_reg); }
    asm volatile("s_waitcnt lgkmcnt(0)" ::: "memory");
    return un_next;
}

DI int attn_unit_band(const Desc& u, unsigned char* lds, int tid, int wid, int lane) {
    constexpr int DQ = 64, NK = 4, KROW = 144, KB = 9216, VB = 8192, OFFV = 6 * KB, OFFS = OFFV + 6 * VB;
    const int r32 = lane & 31, hi = lane >> 5;
    char* K_lds = (char*)lds; char* V_lds = (char*)lds + OFFV;
    float* wsf = (float*)(lds + OFFS) + wid * 64; float* li_l = wsf; float* al_l = wsf + 32;
    const int skey = tid >> 3, sc = tid & 7;
    const int vdst = v_st(skey, sc * 8);
    const int vb0 = (int)(unsigned)(size_t)V_lds + v_rd_base(lane);
    const int nt = u.kt1 - u.kt0;
    bf16x8 kr[6], vr[6];
#pragma unroll
    for (int i = 0; i < 6; ++i) if (i < nt) { const long kb_ = (long)(u.kt0 + i) * 64;
        kr[i] = *(const bf16x8*)(u.k + (kb_ + skey) * u.ldk + sc * 8); vr[i] = *(const bf16x8*)(u.v + (kb_ + skey) * u.ldv + sc * 8); }
    bf16x8 qr[NK];
    { const bf16_t* Qw = u.q + (long)(wid * 32 + r32) * u.ldq + hi * 8;
#pragma unroll
      for (int d0 = 0; d0 < NK; ++d0) qr[d0] = *(const bf16x8*)(Qw + d0 * 16); }
#pragma unroll
    for (int i = 0; i < 6; ++i) if (i < nt) { *(bf16x8*)(K_lds + i * KB + skey * KROW + sc * 16) = kr[i]; *(bf16x8*)(V_lds + i * VB + vdst) = vr[i]; }
    float m_reg = 0.f, l_reg = 0.f; bool started = false;
    f32x16 o0, o1, negm;
#pragma unroll
    for (int r = 0; r < 16; ++r) { o0[r] = 0.f; o1[r] = 0.f; negm[r] = 0.f; }
    const int qrow = u.q0 + wid * 32 + r32;
    const int qmin = u.q0 + wid * 32;
    __syncthreads();
    int un_next = 0;
    if (tid == 0) un_next = (int)__hip_atomic_fetch_add(u.counter, 1u, __ATOMIC_RELAXED, __HIP_MEMORY_SCOPE_AGENT);
    for (int kt = u.kt0; kt < u.kt1; ++kt) {
        const int buf = kt - u.kt0;
        bool active = true;
        active = !((kt * 64 + 63 < qmin - 64) || (kt * 64 > qmin + 31 + 64));
        if (active) {
            f32x16 p0, p1;
            const char* Kb = K_lds + buf * KB;
#pragma unroll
            for (int d0 = 0; d0 < NK; ++d0) { const int cb = (d0 * 16 + hi * 8) * 2;
                const bf16x8 b0 = *(const bf16x8*)(Kb + r32 * KROW + cb);
                const bf16x8 b1 = *(const bf16x8*)(Kb + (32 + r32) * KROW + cb);
                if (d0 == 0) { p0 = __builtin_amdgcn_mfma_f32_32x32x16_bf16(b0, qr[0], negm, 0, 0, 0); p1 = __builtin_amdgcn_mfma_f32_32x32x16_bf16(b1, qr[0], negm, 0, 0, 0); }
                else { p0 = __builtin_amdgcn_mfma_f32_32x32x16_bf16(b0, qr[d0], p0, 0, 0, 0); p1 = __builtin_amdgcn_mfma_f32_32x32x16_bf16(b1, qr[d0], p1, 0, 0, 0); } }
            {
                const int kb = kt * 64 + 4 * hi - qrow;
#pragma unroll
                for (int r = 0; r < 16; ++r) { const int dk = kb + (r & 3) + 8 * (r >> 2);
                    if (dk < -64 || dk > 64) p0[r] = -INFINITY;
                    if (dk + 32 < -64 || dk + 32 > 64) p1[r] = -INFINITY; }
            }
            float pmax = p0[0];
#pragma unroll
            for (int r = 1; r < 16; ++r) pmax = fmaxf(pmax, p0[r]);
#pragma unroll
            for (int r = 0; r < 16; ++r) pmax = fmaxf(pmax, p1[r]);
            pmax = fmaxf(pmax, __shfl_xor(pmax, 32));
            float alpha = 1.f;
            const bool first = !started; started = true;
            if (first || !__all(pmax <= THR2)) {
                const float d = first ? pmax : fmaxf(pmax, 0.f);
                alpha = first ? 1.f : __builtin_amdgcn_exp2f(-d); m_reg += d;
#pragma unroll
                for (int r = 0; r < 16; ++r) { p0[r] -= d; p1[r] -= d; negm[r] = -m_reg; }
            }
            float ps = 0.f;
#pragma unroll
            for (int r = 0; r < 16; ++r) { p0[r] = __builtin_amdgcn_exp2f(p0[r]); p1[r] = __builtin_amdgcn_exp2f(p1[r]); ps += p0[r] + p1[r]; }
            ps += __shfl_xor(ps, 32);
            l_reg = l_reg * alpha + ps;
            if (__any(alpha < 1.f)) {
                if (hi == 0) al_l[r32] = alpha;
                asm volatile("s_waitcnt lgkmcnt(0)" ::: "memory");
#pragma unroll
                for (int r = 0; r < 16; ++r) { const float a = al_l[crow(r, hi)]; o0[r] *= a; o1[r] *= a; }
            }
            bf16x8 pa0, pa1, pa2, pa3;
#define PK4(P, BASE, OUT) do { u32x4 w = {cvtpk(P[BASE + 0], P[BASE + 1]), cvtpk(P[BASE + 2], P[BASE + 3]), cvtpk(P[BASE + 4], P[BASE + 5]), cvtpk(P[BASE + 6], P[BASE + 7])}; \
    OUT = *reinterpret_cast<bf16x8*>(&w); } while (0)
            PK4(p0, 0, pa0); PK4(p0, 8, pa1); PK4(p1, 0, pa2); PK4(p1, 8, pa3);
#undef PK4
            const int vb = vb0 + buf * VB;
            pv_one<0>(o0, vb, pa0, pa1, pa2, pa3);
            pv_one<1>(o1, vb, pa0, pa1, pa2, pa3);
        }
    }
    if (hi == 0) li_l[r32] = l_reg;
    asm volatile("s_waitcnt lgkmcnt(0)" ::: "memory");
    bf16_t* Ow = u.o + (long)(wid * 32) * u.ldo;
#pragma unroll
    for (int r = 0; r < 16; ++r) { const int orow = crow(r, hi); const float rl = 1.0f / li_l[orow];
        Ow[(long)orow * u.ldo + r32] = (bf16_t)f2bf(o0[r] * rl);
        Ow[(long)orow * u.ldo + 32 + r32] = (bf16_t)f2bf(o1[r] * rl); }
    { if (hi == 0) u.lse[(long)(wid * 32 + r32) * u.ldlse] = m_reg + __builtin_amdgcn_logf(l_reg); }
    asm volatile("s_waitcnt lgkmcnt(0)" ::: "memory");
    __syncthreads();
    return un_next;
}
}

constexpr int NU_B = 4 * 4 * 16, NU_A = 4 * 6 * 16, NU_C = 4 * 6 * 48, NU_ALL = NU_B + NU_A + NU_C;
DI void phase_attention(unsigned* counter, unsigned char* lds, int tid, int wid, int lane) {
    unsigned char* ws = PWS;
    const bf16_t* proj = (const bf16_t*)(ws + WS_PROJ); const bf16_t* qb = (const bf16_t*)(ws + WS_QB); const bf16_t* kvb = (const bf16_t*)(ws + WS_KVB);
    bf16_t* yab = (bf16_t*)(ws + WS_YAB); bf16_t* yc = (bf16_t*)(ws + WS_YC); float* lse = (float*)(ws + WS_LSE);
    volatile int* slot = (volatile int*)(lds + att::OFF_Q);
    if (tid == 0) *slot = (int)__hip_atomic_fetch_add(counter, 1u, __ATOMIC_RELAXED, __HIP_MEMORY_SCOPE_AGENT);
    __syncthreads();
    int un = __builtin_amdgcn_readfirstlane(*slot);
    __syncthreads();
    for (;;) {
        if (un >= NU_ALL) break;
        int un_next;
        int tid_u = tid; asm volatile("" : "+v"(tid_u)); const int lane_u = tid_u & 63;
        att::Desc d;
        d.k2 = nullptr; d.ldk2 = 0; d.lse = nullptr; d.ldlse = 0; d.qcs = nullptr; d.q0 = 0; d.counter = counter;
        if (un < NU_B) {
            const int b = un >> 6, h = (un >> 4) & 3, blk = un & 15; const long tok = (long)b * SEQ + blk * 256;
            d.q = qb + tok * 384 + h * 96; d.ldq = 384;
            d.k = kvb + (long)b * SEQ * 512 + h * 128; d.ldk = 512;
            d.k2 = proj + (long)b * SEQ * NPROJ + C_BKR; d.ldk2 = NPROJ;
            d.v = kvb + (long)b * SEQ * 512 + h * 128 + 64; d.ldv = 512;
            d.o = yab + tok * 640 + 384 + h * 64; d.ldo = 640;
            d.qcs = (const float2*)(ws + WS_CSMLA) + (long)(blk * 256) * 16;
            d.kt0 = 0; d.kt1 = SEQ / 64;
            un_next = att::attn_unit<96, false>(d, lds, tid_u, wid, lane_u);
        } else if (un < NU_B + NU_A) {
            const int v = un - NU_B; const int b = v / 96, h = (v / 16) % 6, blk = v & 15; const long tok = (long)b * SEQ + blk * 256;
            d.q = proj + tok * NPROJ + C_AQ + h * 64; d.ldq = NPROJ;
            d.k = proj + (long)b * SEQ * NPROJ + C_AK + (h / 3) * 64; d.ldk = NPROJ;
            d.v = proj + (long)b * SEQ * NPROJ + C_AV + (h / 3) * 64; d.ldv = NPROJ;
            d.o = yab + tok * 640 + h * 64; d.ldo = 640;
            d.kt0 = 0; d.kt1 = SEQ / 64;
            un_next = att::attn_unit<64, false>(d, lds, tid_u, wid, lane_u);
        } else {
            const int v = un - NU_B - NU_A; const int bh = v / 48, w = v % 48; const int b = bh / 6, h = bh % 6;
            int br, r, blk, dil;
            if (w < 16) { br = 0; r = 0; blk = w; dil = 1; } else if (w < 32) { br = 1; r = (w - 16) >> 2; blk = (w - 16) & 3; dil = 4; } else { br = 2; r = w - 32; blk = 0; dil = 16; }
            const int L = SEQ / dil; const long tok0 = (long)b * SEQ + r; const long tq = tok0 + (long)blk * 256 * dil;
            d.q = proj + tq * NPROJ + C_CQ + h * 64; d.ldq = (long)dil * NPROJ;
            d.k = proj + tok0 * NPROJ + C_CK + h * 64; d.ldk = (long)dil * NPROJ;
            d.v = proj + tok0 * NPROJ + C_CV + h * 64; d.ldv = (long)dil * NPROJ;
            d.o = yc + ((long)br * T_TOK + tq) * 384 + h * 64; d.ldo = (long)dil * 384;
            d.lse = lse + ((long)br * T_TOK + tq) * 6 + h; d.ldlse = (long)dil * 6;
            d.q0 = blk * 256;
            d.kt0 = (blk * 4 - 1 < 0) ? 0 : blk * 4 - 1; d.kt1 = (blk * 4 + 5 > L / 64) ? L / 64 : blk * 4 + 5;
            un_next = att::attn_unit_band(d, lds, tid_u, wid, lane_u);
        }
        if (tid == 0) *slot = un_next;
        __syncthreads();
        un = __builtin_amdgcn_readfirstlane(*slot);
        __syncthreads();
    }
}

#define XB_TMO      128
#define XB_XCNT(j)  (256  + 64 * (j))
#define XB_XSUB(j)  (1280 + 64 * (j))
#define XB_XGEN(j)  (2304 + 64 * (j))
#define XB_TOP      3328
#define XB_TOPGEN   3392
#define XCD_BAR_WORDS 3456
#define XB_SPIN_CAP (1u << 18)

__device__ __forceinline__ unsigned xb_ld(unsigned* p)              { return __hip_atomic_load(p, __ATOMIC_RELAXED, __HIP_MEMORY_SCOPE_AGENT); }
__device__ __forceinline__ unsigned xb_add(unsigned* p, unsigned v) { return __hip_atomic_fetch_add(p, v, __ATOMIC_RELAXED, __HIP_MEMORY_SCOPE_AGENT); }
__device__ __forceinline__ unsigned xb_xcc_id() { return (unsigned)__builtin_amdgcn_s_getreg((3 << 11) | 20) & 0xFu; }
#define XB_SPIN(cond, bar) do { unsigned _sp = 0; while (cond) { __builtin_amdgcn_s_sleep(1); \
    if ((++_sp & 255u) == 0u) { if (xb_ld(&(bar)[XB_TMO])) break; if (_sp > XB_SPIN_CAP) { atomicAdd(&(bar)[XB_TMO], 1u); break; } } } } while (0)

struct XcdBarrier {
    unsigned* bar; unsigned x;
    volatile LAS unsigned* st;
};

__device__ __forceinline__ XcdBarrier xcd_barrier_post(unsigned* bar, volatile LAS unsigned* st) {
    XcdBarrier b; b.bar = bar; b.x = xb_xcc_id(); b.st = st;
    if (threadIdx.x == 0) (void)xb_add(&bar[XB_XCNT(b.x)], 1u);
    return b;
}
__device__ __forceinline__ void xcd_barrier_complete(unsigned* bar, unsigned x, unsigned& nloc, unsigned& nx) {
    const unsigned G = gridDim.x * gridDim.y * gridDim.z;
    unsigned sum, cnt, mine, sp = 0u;
    for (;;) {
        sum = 0u; cnt = 0u; mine = 0u;
#pragma unroll
        for (unsigned j = 0; j < 16; ++j) { const unsigned c = xb_ld(&bar[XB_XCNT(j)]); sum += c; cnt += (c > 0u) ? 1u : 0u; mine = (j == x) ? c : mine; }
        if (sum == G) break;
        __builtin_amdgcn_s_sleep(1);
        if ((++sp & 255u) == 0u) { if (xb_ld(&bar[XB_TMO])) break; if (sp > XB_SPIN_CAP) { atomicAdd(&bar[XB_TMO], 1u); break; } }
    }
    nloc = mine > 0u ? mine : 1u; nx = cnt > 0u ? cnt : 1u;
}

__device__ __forceinline__ void xcd_barrier(const XcdBarrier& b) {
    asm volatile("s_waitcnt vmcnt(0)" ::: "memory");
    __syncthreads();
    if (threadIdx.x == 0) {
        unsigned* bar = b.bar;
        __builtin_amdgcn_s_waitcnt(0);
        unsigned nloc = b.st[0], nx = b.st[1];
        if (nloc == 0u) { xcd_barrier_complete(bar, b.x, nloc, nx); b.st[0] = nloc; b.st[1] = nx; }
        const unsigned old = xb_add(&bar[XB_XSUB(b.x)], 1u);
        const unsigned gen = old / nloc;
        if (old + 1u == (gen + 1u) * nloc) {
            __builtin_amdgcn_fence(__ATOMIC_RELEASE, "agent");
            asm volatile("s_waitcnt vmcnt(0)" ::: "memory");
            const unsigned og = xb_add(&bar[XB_TOP], 1u);
            const unsigned tg = og / nx;
            if (og + 1u == (tg + 1u) * nx) xb_add(&bar[XB_TOPGEN], 1u);
            else XB_SPIN(xb_ld(&bar[XB_TOPGEN]) == tg, bar);
            __builtin_amdgcn_fence(__ATOMIC_ACQUIRE, "agent");
            xb_add(&bar[XB_XGEN(b.x)], 1u);
            asm volatile("s_waitcnt vmcnt(0)" ::: "memory");
        } else {
            XB_SPIN(xb_ld(&bar[XB_XGEN(b.x)]) == gen, bar);
            __builtin_amdgcn_fence(__ATOMIC_ACQUIRE, "agent");
            asm volatile("s_waitcnt vmcnt(0)" ::: "memory");
        }
    }
    __syncthreads();
}

__global__ void __launch_bounds__(512, 2) mega_fwd(Params p) {
    extern __shared__ __attribute__((aligned(16))) unsigned char lds[];
    cg::grid_group grid = cg::this_grid();
    const int tid = threadIdx.x, lane = tid & 63, wave = __builtin_amdgcn_readfirstlane(tid >> 6);
    const int bid = blockIdx.x, G = gridDim.x;
    const int gw = bid * 8 + wave, NGW = G * 8;
    unsigned char* ws = PWS;
    PG8_LAS unsigned char* lds3 = (PG8_LAS unsigned char*)lds;
    bf16_t* H = (bf16_t*)(ws + WS_H);
    const float* mod = (const float*)(ws + WS_MOD);

    volatile LAS unsigned* bst = (volatile LAS unsigned*)((LAS unsigned char*)lds + 139264);
    if (tid < 2) bst[tid] = 0u;
    { const int gt0 = bid * 512 + tid; if (gt0 < 8192) ((unsigned*)(ws + WS_CTL))[gt0] = 0u; }
    __syncthreads();
    phase_prologue(lds, bid, G, tid, lane, wave);
    grid.sync();
    const XcdBarrier xbar = xcd_barrier_post((unsigned*)(ws + WS_CTL) + 1024, bst);
#define GRID_SYNC() xcd_barrier(xbar)

#define FRESH_IDS() int tid_f = threadIdx.x; asm volatile("" : "+v"(tid_f)); const int lane_f = tid_f & 63, wave_f = __builtin_amdgcn_readfirstlane(tid_f >> 6), gw_f = bid * 8 + wave_f; (void)lane_f; (void)gw_f
    for (int l = 0; l < 2; ++l) {
        const float* modl = mod + (size_t)l * 4 * NMOD;
        const float* xin = (l == 0) ? PIN(0) : POUT;
        if (l == 0) {
            FRESH_IDS(); phase_prenorm(xin, PIN(4), modl, 1024, H, (float*)(ws + WS_SSQ1), gw_f, NGW, lane_f);
#pragma unroll 1
            for (int ll = 0; ll < 2; ++ll) { const float* ml = mod + (size_t)ll * 4 * NMOD;
                vecmat4(ml, NMOD, PIN(6) + (size_t)ll * 1024 * 2208, 2208, 36, (float*)(ws + WS_BIAS1) + (size_t)ll * 4 * NPROJ, NPROJ, lds, (bid + G - (ll * 100) % G) % G, G, tid_f, lane_f, wave_f);
                vecmat4(ml + 3072, NMOD, PIN(15) + (size_t)ll * 1024 * DFF, DFF, DFF / 64, (float*)(ws + WS_BIAS2) + (size_t)ll * 4 * DFF, DFF, lds, (bid + G - (36 + ll * 100) % G) % G, G, tid_f, lane_f, wave_f); }
            GRID_SYNC();
        }
        { pg8::Gemm g{H, (const bf16_t*)(ws + WS_WIN) + (size_t)l * NPROJ * 1024, T_TOK, 2048, DM}; pg8::StaticOrder S; S.init(T_TOK, 2048, G, bid);
          pg8::EpiStoreRS<0> E{(bf16_t*)(ws + WS_PROJ), NPROJ, (const float*)(ws + WS_SSQ1) + (size_t)l * T_TOK, (const float*)(ws + WS_BIAS1) + (size_t)l * 4 * NPROJ, NPROJ};
          pg8::gemm_phase<pg8::EpiStoreRS<0>, pg8::StaticOrder, true, true>(lds3, g, S, E); }
        GRID_SYNC();
        { const int nbig = G / 4;
          if (bid < nbig) { pg8::Gemm g{H, (const bf16_t*)(ws + WS_WIN) + (size_t)l * NPROJ * 1024 + (size_t)2048 * 1024, T_TOK, 256, DM}; pg8::StaticOrder S; S.init(T_TOK, 256, nbig, bid);
              pg8::EpiStoreRS<0> E{(bf16_t*)(ws + WS_PROJ) + 2048, NPROJ, (const float*)(ws + WS_SSQ1) + (size_t)l * T_TOK, (const float*)(ws + WS_BIAS1) + (size_t)l * 4 * NPROJ + 2048, NPROJ};
              pg8::gemm_phase<pg8::EpiStoreRS<0>, pg8::StaticOrder, true, true>(lds3, g, S, E); }
          else { FRESH_IDS(); phase_post(l, (bid - nbig) * 8 + wave_f, (G - nbig) * 8, lane_f); } }
        GRID_SYNC();
        { const int half = G / 2;
          if (bid < half) { pg8::Gemm g{(const bf16_t*)(ws + WS_BQN), (const bf16_t*)(ws + WS_WUQ) + (size_t)l * 512 * 256, T_TOK, 512, 256}; pg8::StaticOrder S; S.init(T_TOK, 512, half, bid);
              pg8::EpiStore<0> E{(bf16_t*)(ws + WS_QB), 384, 384};
              pg8::gemm_phase<pg8::EpiStore<0>, pg8::StaticOrder, true, true>(lds3, g, S, E); }
          else { pg8::Gemm g{(const bf16_t*)(ws + WS_BKVN), (const bf16_t*)(ws + WS_WUKV) + (size_t)l * 512 * 128, T_TOK, 512, 128}; pg8::StaticOrder S; S.init(T_TOK, 512, G - half, bid - half);
              pg8::EpiStore<0> E{(bf16_t*)(ws + WS_KVB), 512, 512};
              pg8::gemm_phase<pg8::EpiStore<0>, pg8::StaticOrder, true, true>(lds3, g, S, E); } }
        GRID_SYNC();
        { FRESH_IDS(); phase_attention((unsigned*)(ws + WS_CTL) + 64 * l, lds, tid_f, wave_f, lane_f); }
        GRID_SYNC();
        { FRESH_IDS(); phase_merge(l, gw_f, NGW, lane_f); }
        GRID_SYNC();
        { pg8::Gemm g{H, (const bf16_t*)(ws + WS_WOUT) + (size_t)l * 1024 * 1024, T_TOK, DM, DM}; pg8::StaticOrder S; S.init(T_TOK, DM, G, bid);
          pg8::EpiResidH E{xin, POUT, modl + 2048, PIN(5) + l * DM, modl + 4096, (bf16_t*)(ws + WS_H2), (float*)(ws + WS_SSQ) + (size_t)l * T_TOK};
          pg8::gemm_phase<pg8::EpiResidH, pg8::StaticOrder, true, true>(lds3, g, S, E); }
        GRID_SYNC();
        { pg8::Gemm g{(const bf16_t*)(ws + WS_H2), (const bf16_t*)(ws + WS_WFF1) + (size_t)l * DFF * 1024, T_TOK, DFF, DM}; pg8::StaticOrder S; S.init(T_TOK, DFF, G, bid);
          pg8::EpiStoreRS<2> E{(bf16_t*)(ws + WS_HID), DFF, (const float*)(ws + WS_SSQ) + (size_t)l * T_TOK, (const float*)(ws + WS_BIAS2) + (size_t)l * 4 * DFF, DFF};
          pg8::gemm_phase<pg8::EpiStoreRS<2>, pg8::StaticOrder, true, true>(lds3, g, S, E); }
        GRID_SYNC();
        { pg8::Gemm g{(const bf16_t*)(ws + WS_HID), (const bf16_t*)(ws + WS_WFF2) + (size_t)l * 1024 * DFF, T_TOK, DM, DFF}; pg8::StaticOrder S; S.init(T_TOK, DM, G, bid);
          pg8::EpiResidH E{POUT, POUT, modl + 5120, PIN(4) + DM, mod + (size_t)4 * NMOD + 1024, (l == 0) ? H : (bf16_t*)nullptr, (float*)(ws + WS_SSQ1) + T_TOK};
          pg8::gemm_phase<pg8::EpiResidH, pg8::StaticOrder, true, true>(lds3, g, S, E); }
        GRID_SYNC();
    }
    { FRESH_IDS(); phase_final_norm(POUT, PIN(17), gw_f, NGW, lane_f); }
}

extern "C" void kernel_launch(void* const* d_in, const int* in_sizes, int n_in, void* d_out, int out_size, void* d_ws, size_t ws_size, hipStream_t stream) {
    static int grid_blocks = 0;
    if (grid_blocks == 0) {
        if (n_in != 18 || out_size != T_TOK * DM || ws_size < WS_END) { fprintf(stderr, "kernel_launch: unexpected shapes (n_in %d out %d ws %zu)\n", n_in, out_size, ws_size); grid_blocks = -1; return; }
        int dev = 0, cus = 0, per_cu = 0;
        (void)hipGetDevice(&dev);
        (void)hipDeviceGetAttribute(&cus, hipDeviceAttributeMultiprocessorCount, dev);
        if (hipFuncSetAttribute((const void*)mega_fwd, hipFuncAttributeMaxDynamicSharedMemorySize, LDS_BYTES) != hipSuccess) { fprintf(stderr, "kernel_launch: hipFuncSetAttribute failed\n"); grid_blocks = -1; return; }
        if (hipOccupancyMaxActiveBlocksPerMultiprocessor(&per_cu, (const void*)mega_fwd, 512, LDS_BYTES) != hipSuccess || per_cu < 1) { fprintf(stderr, "kernel_launch: the occupancy query reports %d resident workgroups per CU for this kernel (512 threads, %d B LDS); nothing launched\n", per_cu, LDS_BYTES); (void)hipGetLastError(); grid_blocks = -1; return; }
        grid_blocks = cus * 1;
        if (per_cu < 1) grid_blocks = -1;
    }
    if (grid_blocks < 0) return;
    Params p{};
    for (int i = 0; i < 18; ++i) p.in[i] = (const float*)d_in[i];
    p.out = (float*)d_out; p.ws = (unsigned char*)d_ws;
    void* args[] = {&p};
    hipError_t e = hipLaunchCooperativeKernel((const void*)mega_fwd, dim3(grid_blocks), dim3(512), args, LDS_BYTES, stream);
    if (e != hipSuccess) fprintf(stderr, "cooperative launch failed: %s (grid %d)\n", hipGetErrorString(e), grid_blocks);
}
```

```cpp
#include <hip/hip_runtime.h>
#include <hip/hip_cooperative_groups.h>
#include <cstdio>
#include <cstdint>
namespace cg = cooperative_groups;
namespace pg8 {
#define PG8_LAS __attribute__((address_space(3)))
typedef unsigned short bf16_t;
typedef short bf16x8 __attribute__((ext_vector_type(8)));
typedef float f32x4 __attribute__((ext_vector_type(4)));
typedef unsigned u32x4 __attribute__((ext_vector_type(4)));
constexpr int BM = 256, BK = 64, HALF = 128, HTB = HALF * BK * 2  , STAGE_BYTES = 8 * HTB, NXCD = 8, WGM = 2;

__host__ __device__ __forceinline__ int lds_byte(int r, int c) { const int st = (r >> 4) * 2 + (c >> 5), rr = r & 15, cc = c & 31, ob = rr * 64 + cc * 2; return st * 1024 + (ob ^ (((ob >> 9) & 1) << 5)); }
__host__ __device__ __forceinline__ void stage_rc(int b, int& R, int& C) { const int st = b / 1024, sb = b % 1024, swz = sb ^ (((sb >> 9) & 1) << 5); R = (st >> 1) * 16 + swz / 64; C = (st & 1) * 32 + (swz % 64) / 2; }
__host__ __device__ __forceinline__ int perm32(int rho) { const int n = rho >> 4, i = rho & 15; return 8 * (i >> 2) + 4 * n + (i & 3); }

struct Unit { int pm, pn; };
struct Gemm { const bf16_t* A; const bf16_t* Bt; int M, N, K; };

struct StaticOrder {
    int nM, nN, nwg, G, c;
    __host__ __device__ void init(int M, int N, int G_, int c_) { nM = M / BM; nN = N / BM; nwg = nM * nN; G = G_; c = c_; }
    __host__ __device__ bool next(int i, Unit& u) const {
        const long L = (long)i * G + c; if (L >= nwg) return false;
        int wgid = (int)L; { const int q = nwg / NXCD, r = nwg % NXCD, xcd = wgid % NXCD, off = wgid / NXCD; wgid = (xcd < r ? xcd * (q + 1) : r * (q + 1) + (xcd - r) * q) + off; }
        const int nig = WGM * nN, gid = wgid / nig, fm = gid * WGM, gsz = (nM - fm) < WGM ? (nM - fm) : WGM;
        u.pm = fm + ((wgid % nig) % gsz); u.pn = (wgid % nig) / gsz; return true;
    }
    __device__ __forceinline__ void a_ready(const Unit&) const {}
    __device__ __forceinline__ void done(const Unit&) const {}
};

__device__ __forceinline__ unsigned cvt_pk_bf16(float lo, float hi) { unsigned r; asm volatile("v_cvt_pk_bf16_f32 %0, %1, %2" : "=v"(r) : "v"(lo), "v"(hi)); return r; }
typedef float f32x2 __attribute__((ext_vector_type(2)));

template <int ACT> struct EpiStore {
    static constexpr bool PERM = true, AFTER_DRAIN = false;
    bf16_t* O; int ldc; int nvalid;
    __device__ __forceinline__ void operator()(const f32x4 (&acc)[2][2][4][2], const Unit& u, int wr, int wc, int fr_, int fq_) const {
        int ln = __builtin_amdgcn_mbcnt_hi(~0u, __builtin_amdgcn_mbcnt_lo(~0u, 0u)); asm volatile("" : "+v"(ln)); const int fr = ln & 15, fq = ln >> 4;
        const int row0 = u.pm * BM + wr * 64 + fr; const int col0 = u.pn * BM + wc * 32 + 8 * fq;
#pragma unroll
        for (int ai = 0; ai < 2; ++ai)
#pragma unroll
            for (int m = 0; m < 4; ++m) { bf16_t* rowp = O + (size_t)(row0 + ai * HALF + m * 16) * ldc;
#pragma unroll
                for (int bj = 0; bj < 2; ++bj) { const int c = col0 + bj * HALF;
                    if (c < nvalid) { f32x4 v0 = acc[ai][bj][m][0], v1 = acc[ai][bj][m][1];
                        if (ACT == 2) { v0 = __builtin_elementwise_max(v0, (f32x4){0.f, 0.f, 0.f, 0.f}); v1 = __builtin_elementwise_max(v1, (f32x4){0.f, 0.f, 0.f, 0.f}); v0 = v0 * v0; v1 = v1 * v1; }
                        u32x4 w; w.x = cvt_pk_bf16(v0[0], v0[1]); w.y = cvt_pk_bf16(v0[2], v0[3]); w.z = cvt_pk_bf16(v1[0], v1[1]); w.w = cvt_pk_bf16(v1[2], v1[3]);
                        *(u32x4*)(rowp + c) = w; } } }
    }
};
struct EpiResid {
    static constexpr bool PERM = false, AFTER_DRAIN = false;
    const float* base; float* out; const float* gate;
    __device__ __forceinline__ void operator()(const f32x4 (&acc)[2][2][4][2], const Unit& u, int wr, int wc, int fr_, int fq_) const {
        int ln = __builtin_amdgcn_mbcnt_hi(~0u, __builtin_amdgcn_mbcnt_lo(~0u, 0u)); asm volatile("" : "+v"(ln)); const int fr = ln & 15, fq = ln >> 4;
        const float* g = gate + (size_t)((u.pm * BM) >> 12) * 6144;
        const int col0 = u.pn * BM + wc * 32 + 4 * fq;
#pragma unroll
        for (int bj = 0; bj < 2; ++bj)
#pragma unroll
            for (int n = 0; n < 2; ++n) { const int col = col0 + bj * HALF + n * 16; const f32x4 gv = *(const f32x4*)(g + col);
#pragma unroll
                for (int ai = 0; ai < 2; ++ai)
#pragma unroll
                    for (int m = 0; m < 4; ++m) { const size_t off = (size_t)(u.pm * BM + ai * HALF + wr * 64 + m * 16 + fr) * 1024 + col;
                        const f32x4 b = *(const f32x4*)(base + off); *(f32x4*)(out + off) = b + gv * acc[ai][bj][m][n]; } }
    }
};
typedef unsigned u32x2v __attribute__((ext_vector_type(2)));
struct EpiResidH {
    static constexpr bool PERM = false, AFTER_DRAIN = false;
    const float* base; float* out; const float* gate; const float* nw; const float* sc; bf16_t* H2; float* ssq;
    __device__ __forceinline__ void operator()(const f32x4 (&acc)[2][2][4][2], const Unit& u, int wr, int wc, int fr_, int fq_) const {
        int ln = __builtin_amdgcn_mbcnt_hi(~0u, __builtin_amdgcn_mbcnt_lo(~0u, 0u)); asm volatile("" : "+v"(ln)); const int fr = ln & 15, fq = ln >> 4;
        const size_t boff = (size_t)((u.pm * BM) >> 12) * 6144;
        const float* g = gate + boff; const float* scb = sc + boff;
        const int col0 = u.pn * BM + wc * 32 + 4 * fq;
        f32x4 gv[2][2], cv[2][2];
#pragma unroll
        for (int bj = 0; bj < 2; ++bj)
#pragma unroll
            for (int n = 0; n < 2; ++n) { const int col = col0 + bj * HALF + n * 16; gv[bj][n] = *(const f32x4*)(g + col); cv[bj][n] = *(const f32x4*)(nw + col) * (*(const f32x4*)(scb + col) + 1.0f); }
#pragma unroll
        for (int ai = 0; ai < 2; ++ai)
#pragma unroll
            for (int m = 0; m < 4; ++m) { const int row = u.pm * BM + ai * HALF + wr * 64 + m * 16 + fr; float sq = 0.f;
#pragma unroll
                for (int bj = 0; bj < 2; ++bj)
#pragma unroll
                    for (int n = 0; n < 2; ++n) { const size_t off = (size_t)row * 1024 + col0 + bj * HALF + n * 16;
                        const f32x4 o = *(const f32x4*)(base + off) + gv[bj][n] * acc[ai][bj][m][n]; *(f32x4*)(out + off) = o;
                        sq += (o.x * o.x + o.y * o.y) + (o.z * o.z + o.w * o.w);
                        if (H2) { const f32x4 h = o * cv[bj][n]; u32x2v w; w.x = cvt_pk_bf16(h.x, h.y); w.y = cvt_pk_bf16(h.z, h.w); *(u32x2v*)(H2 + off) = w; } }
                { auto r = __builtin_amdgcn_permlane16_swap(__float_as_uint(sq), __float_as_uint(sq), false, false); sq = __uint_as_float(r[0]) + __uint_as_float(r[1]); }
                { auto r = __builtin_amdgcn_permlane32_swap(__float_as_uint(sq), __float_as_uint(sq), false, false); sq = __uint_as_float(r[0]) + __uint_as_float(r[1]); }
                if (H2 && fq == 0) (void)__hip_atomic_fetch_add(ssq + row, sq, __ATOMIC_RELAXED, __HIP_MEMORY_SCOPE_AGENT); }
    }
};
template <int ACT> struct EpiStoreRS {
    static constexpr bool PERM = true, AFTER_DRAIN = false;
    bf16_t* O; int ldc; const float* ssq; const float* bias; int ldb;
    __device__ __forceinline__ void operator()(const f32x4 (&acc)[2][2][4][2], const Unit& u, int wr, int wc, int fr_, int fq_) const {
        int ln = __builtin_amdgcn_mbcnt_hi(~0u, __builtin_amdgcn_mbcnt_lo(~0u, 0u)); asm volatile("" : "+v"(ln)); const int fr = ln & 15, fq = ln >> 4;
        const int row0 = u.pm * BM + wr * 64 + fr; const int col0 = u.pn * BM + wc * 32 + 8 * fq;
        const float* bb = bias + (size_t)((u.pm * BM) >> 12) * ldb + col0;
        f32x4 bv[2][2];
#pragma unroll
        for (int bj = 0; bj < 2; ++bj) { bv[bj][0] = *(const f32x4*)(bb + bj * HALF); bv[bj][1] = *(const f32x4*)(bb + bj * HALF + 4); }
#pragma unroll
        for (int ai = 0; ai < 2; ++ai)
#pragma unroll
            for (int m = 0; m < 4; ++m) { const int row = row0 + ai * HALF + m * 16; const float rs = 1.0f / sqrtf(ssq[row] * (1.0f / 1024.0f) + 1e-6f);
                bf16_t* rowp = O + (size_t)row * ldc;
#pragma unroll
                for (int bj = 0; bj < 2; ++bj) { f32x4 v0 = acc[ai][bj][m][0] * rs + bv[bj][0], v1 = acc[ai][bj][m][1] * rs + bv[bj][1];
                    if (ACT == 2) { v0 = __builtin_elementwise_max(v0, (f32x4){0.f, 0.f, 0.f, 0.f}); v1 = __builtin_elementwise_max(v1, (f32x4){0.f, 0.f, 0.f, 0.f}); v0 = v0 * v0; v1 = v1 * v1; }
                    u32x4 w; w.x = cvt_pk_bf16(v0[0], v0[1]); w.y = cvt_pk_bf16(v0[2], v0[3]); w.z = cvt_pk_bf16(v1[0], v1[1]); w.w = cvt_pk_bf16(v1[2], v1[3]);
                    *(u32x4*)(rowp + col0 + bj * HALF) = w; } }
    }
};
template <class Epi, class Sched, bool ALIGN_EPI = false, bool SP2 = false>
__device__ __forceinline__ void gemm_phase(PG8_LAS unsigned char* lds, const Gemm g, const Sched& S, const Epi& E) {
    int tid_raw = threadIdx.x; asm volatile("" : "+v"(tid_raw));
    const int tid = tid_raw, wid = __builtin_amdgcn_readfirstlane(tid >> 6), lane = tid & 63, wr = wid >> 2, wc = wid & 3, fr = lane & 15, fq = lane >> 4;
    const int K = g.K, nt = K / BK;
    unsigned voffA[2], voffB[2];
#pragma unroll
    for (int i = 0; i < 2; ++i) { int R, C; stage_rc(tid * 16 + i * 8192, R, C); const int Rb = Epi::PERM ? ((R & ~31) + perm32(R & 31)) : R;
        voffA[i] = (unsigned)(R * K + C) * 2u; voffB[i] = (unsigned)(Rb * K + C) * 2u; }
    const size_t kstep = (size_t)(BK * 2);
    const size_t hstep = (size_t)HALF * K * 2;
    const size_t tstep = 2 * hstep;
    const unsigned ldsw = (unsigned)wid * 1024u;
    const int aoff = lds_byte(wr * 64 + fr, fq * 8), boff = lds_byte(wc * 32 + fr, fq * 8);
#define PG8_SA(b, h) (((b) * 2 + (h)) * HTB)
#define PG8_SB(b, h) ((4 + (b) * 2 + (h)) * HTB)
#define PG8_STAGE(bufoff, gbase, voff) do { _Pragma("unroll") for (int _i = 0; _i < 2; ++_i) \
        __builtin_amdgcn_global_load_lds((const unsigned*)((const char*)(gbase) + (voff)[_i]), (PG8_LAS unsigned*)(lds + (bufoff) + ldsw + _i * 8192), 16, 0, 0); } while (0)
#define PG8_LDA(dst, b, h) do { _Pragma("unroll") for (int m = 0; m < 4; ++m) _Pragma("unroll") for (int k = 0; k < 2; ++k) dst[m][k] = *(const PG8_LAS bf16x8*)(lds + PG8_SA(b, h) + aoff + m * 2048 + k * 1024); } while (0)
#define PG8_LDB(dst, b, h) do { _Pragma("unroll") for (int n = 0; n < 2; ++n) _Pragma("unroll") for (int k = 0; k < 2; ++k) dst[n][k] = *(const PG8_LAS bf16x8*)(lds + PG8_SB(b, h) + boff + n * 2048 + k * 1024); } while (0)
#define PG8_MMA(ai, bj, At, Bt) do { __builtin_amdgcn_s_setprio(1); _Pragma("unroll") for (int m = 0; m < 4; ++m) _Pragma("unroll") for (int n = 0; n < 2; ++n) _Pragma("unroll") for (int k = 0; k < 2; ++k) \
        acc[ai][bj][m][n] = __builtin_amdgcn_mfma_f32_16x16x32_bf16(Bt[n][k], At[m][k], acc[ai][bj][m][n], 0, 0, 0); __builtin_amdgcn_s_setprio(0); } while (0)
#define PG8_WAIT_V(n) asm volatile("s_waitcnt vmcnt(" #n ")" ::: "memory")
#define PG8_WAIT_L(n) asm volatile("s_waitcnt lgkmcnt(" #n ")" ::: "memory")
#define PG8_BAR __builtin_amdgcn_s_barrier()
#define PG8_SCHED __builtin_amdgcn_sched_barrier(0)
    Unit cur, nxt; int ui = 0;
    if (!S.next(0, cur)) return;
    f32x4 acc[2][2][4][2];
#pragma unroll
    for (int a = 0; a < 2; ++a)
#pragma unroll
        for (int b = 0; b < 2; ++b)
#pragma unroll
            for (int m = 0; m < 4; ++m)
#pragma unroll
                for (int n = 0; n < 2; ++n) acc[a][b][m][n] = (f32x4){0.f, 0.f, 0.f, 0.f};
    bf16x8 At[4][2], B0[2][2], B1[2][2];
    const char* cA = (const char*)g.A + (size_t)cur.pm * tstep; const char* cB = (const char*)g.Bt + (size_t)cur.pn * tstep;
    S.a_ready(cur);
    if constexpr (SP2) {
        PG8_STAGE(PG8_SB(0, 0), cB, voffB); PG8_STAGE(PG8_SB(0, 1), cB + hstep, voffB); PG8_STAGE(PG8_SA(0, 0), cA, voffA); PG8_STAGE(PG8_SA(0, 1), cA + hstep, voffA);
        if (wr == 1) PG8_BAR;
        PG8_WAIT_V(2); PG8_BAR;
        PG8_STAGE(PG8_SB(1, 0), cB + kstep, voffB); PG8_STAGE(PG8_SA(1, 0), cA + kstep, voffA); PG8_STAGE(PG8_SB(1, 1), cB + hstep + kstep, voffB);
        PG8_WAIT_V(6); PG8_BAR;
    } else {
        PG8_STAGE(PG8_SB(0, 0), cB, voffB); PG8_STAGE(PG8_SA(0, 0), cA, voffA); PG8_STAGE(PG8_SB(0, 1), cB + hstep, voffB); PG8_STAGE(PG8_SA(0, 1), cA + hstep, voffA);
        if (wr == 1) PG8_BAR;
        PG8_WAIT_V(4); PG8_BAR;
        PG8_STAGE(PG8_SB(1, 0), cB + kstep, voffB); PG8_STAGE(PG8_SA(1, 0), cA + kstep, voffA); PG8_STAGE(PG8_SB(1, 1), cB + hstep + kstep, voffB);
        PG8_WAIT_V(6); PG8_BAR;
    }
    for (;;) {
        const bool has_next = S.next(ui + 1, nxt);
        const char* nA = has_next ? (const char*)g.A + (size_t)nxt.pm * tstep : cA; const char* nB = has_next ? (const char*)g.Bt + (size_t)nxt.pn * tstep : cB;
        for (int t = 0; t < nt; t += 2) {
            const bool last = (t == nt - 2);
            const char* a1 = cA + (size_t)(t + 1) * kstep;
            const char* a2 = last ? nA : cA + (size_t)(t + 2) * kstep; const char* b2 = last ? nB : cB + (size_t)(t + 2) * kstep;
            const char* a3 = a2 + kstep; const char* b3 = b2 + kstep;
            if (last && has_next) S.a_ready(nxt);
            if constexpr (SP2) {
            PG8_LDB(B0, 0, 0); PG8_LDB(B1, 0, 1); PG8_SCHED; PG8_LDA(At, 0, 0); PG8_STAGE(PG8_SA(1, 1), a1 + hstep, voffA);
            PG8_WAIT_V(8); PG8_WAIT_L(0); PG8_BAR; PG8_MMA(0, 0, At, B0); PG8_MMA(0, 1, At, B1); PG8_BAR; PG8_SCHED;
            PG8_LDA(At, 0, 1); PG8_STAGE(PG8_SB(0, 0), b2, voffB); PG8_STAGE(PG8_SB(0, 1), b2 + hstep, voffB); PG8_STAGE(PG8_SA(0, 0), a2, voffA);
            PG8_WAIT_V(8); PG8_WAIT_L(0); PG8_BAR; PG8_MMA(1, 0, At, B0); PG8_MMA(1, 1, At, B1); PG8_BAR; PG8_SCHED;
            PG8_LDB(B0, 1, 0); PG8_LDB(B1, 1, 1); PG8_SCHED; PG8_LDA(At, 1, 0); PG8_STAGE(PG8_SA(0, 1), a2 + hstep, voffA);
            PG8_WAIT_V(8); PG8_WAIT_L(0); PG8_BAR; PG8_MMA(0, 0, At, B0); PG8_MMA(0, 1, At, B1); PG8_BAR; PG8_SCHED;
            PG8_LDA(At, 1, 1); PG8_STAGE(PG8_SB(1, 0), b3, voffB); PG8_STAGE(PG8_SB(1, 1), b3 + hstep, voffB); PG8_STAGE(PG8_SA(1, 0), a3, voffA);
            PG8_WAIT_V(8); PG8_WAIT_L(0); PG8_BAR; PG8_MMA(1, 0, At, B0); PG8_MMA(1, 1, At, B1); PG8_BAR; PG8_SCHED;
            } else {
            PG8_LDB(B0, 0, 0); PG8_SCHED; PG8_LDA(At, 0, 0); PG8_STAGE(PG8_SA(1, 1), a1 + hstep, voffA);
            PG8_WAIT_L(8); PG8_BAR; PG8_WAIT_L(0); PG8_MMA(0, 0, At, B0); PG8_BAR; PG8_SCHED;
            PG8_LDB(B1, 0, 1); PG8_STAGE(PG8_SB(0, 0), b2, voffB);
            PG8_BAR; PG8_WAIT_L(0); PG8_MMA(0, 1, At, B1); PG8_BAR;
            PG8_LDA(At, 0, 1); PG8_STAGE(PG8_SA(0, 0), a2, voffA);
            PG8_BAR; PG8_WAIT_L(0); PG8_MMA(1, 0, At, B0); PG8_BAR; PG8_SCHED;
            PG8_STAGE(PG8_SB(0, 1), b2 + hstep, voffB);
            PG8_WAIT_V(6); PG8_BAR; PG8_MMA(1, 1, At, B1); PG8_BAR;
            PG8_LDB(B0, 1, 0); PG8_SCHED; PG8_LDA(At, 1, 0); PG8_STAGE(PG8_SA(0, 1), a2 + hstep, voffA);
            PG8_WAIT_L(8); PG8_BAR; PG8_WAIT_L(0); PG8_MMA(0, 0, At, B0); PG8_BAR; PG8_SCHED;
            PG8_LDB(B1, 1, 1); PG8_STAGE(PG8_SB(1, 0), b3, voffB);
            PG8_BAR; PG8_WAIT_L(0); PG8_MMA(0, 1, At, B1); PG8_BAR;
            PG8_LDA(At, 1, 1); PG8_STAGE(PG8_SA(1, 0), a3, voffA);
            PG8_BAR; PG8_WAIT_L(0); PG8_MMA(1, 0, At, B0); PG8_BAR; PG8_SCHED;
            PG8_STAGE(PG8_SB(1, 1), b3 + hstep, voffB);
            PG8_WAIT_V(6); PG8_BAR; PG8_MMA(1, 1, At, B1); PG8_BAR;
            }
        }
        if constexpr (ALIGN_EPI) { if (wr == 0) PG8_BAR; }
        if constexpr (!Epi::AFTER_DRAIN) { E(acc, cur, wr, wc, fr, fq); S.done(cur); }
        if (!has_next) break;
#pragma unroll
        for (int a = 0; a < 2; ++a)
#pragma unroll
            for (int b = 0; b < 2; ++b)
#pragma unroll
                for (int m = 0; m < 4; ++m)
#pragma unroll
                    for (int n = 0; n < 2; ++n) acc[a][b][m][n] = (f32x4){0.f, 0.f, 0.f, 0.f};
        cur = nxt; cA = nA; cB = nB; ++ui;
        if constexpr (ALIGN_EPI) { if (wr == 1) PG8_BAR; }
    }
    PG8_WAIT_V(0);
    if constexpr (!ALIGN_EPI) { if (wr == 0) PG8_BAR; }
    PG8_BAR;
    if constexpr (Epi::AFTER_DRAIN) { E.fused(acc, cur, wr, wc, fr, fq, lds, wid, lane); S.done(cur); }
#undef PG8_SA
#undef PG8_SB
#undef PG8_STAGE
#undef PG8_LDA
#undef PG8_LDB
#undef PG8_MMA
#undef PG8_WAIT_V
#undef PG8_WAIT_L
#undef PG8_BAR
#undef PG8_SCHED
}
}

#define DI __device__ __forceinline__
#define LAS __attribute__((address_space(3)))
typedef unsigned short bf16_t;
typedef float f32x4 __attribute__((ext_vector_type(4)));
typedef unsigned u32x4 __attribute__((ext_vector_type(4)));
typedef unsigned u32x2 __attribute__((ext_vector_type(2)));
constexpr int T_TOK = 16384, SEQ = 4096, DM = 1024, NPROJ = 2304, DFF = 4096, NMOD = 6144;
constexpr float EPS = 1e-6f;
constexpr float LOG2E = 1.4426950408889634f;
constexpr float QSCALE64 = 0.125f * LOG2E;
constexpr float QSCALE96 = 0.10206207261596577f * LOG2E;
constexpr int C_AQ = 0, C_AK = 384, C_AV = 512, C_BQ = 640, C_BKV = 896, C_BKR = 1024, C_CQ = 1056, C_CK = 1440, C_CV = 1824;
constexpr size_t MiB = 1u << 20;
constexpr size_t WS_CTL = 0, WS_MOD = 65536;
constexpr size_t WS_CSAX = 1 * MiB, WS_CSDIL = 2 * MiB, WS_CSMLA = 3 * MiB;
constexpr size_t WS_WIN = 4 * MiB, WS_WOUT = 13 * MiB, WS_WFF1 = 17 * MiB, WS_WFF2 = 33 * MiB, WS_WUQ = 49 * MiB, WS_WUKV = 49 * MiB + 512 * 1024;
constexpr size_t WS_H = 50 * MiB, WS_PROJ = 82 * MiB, WS_QB = 154 * MiB, WS_KVB = 166 * MiB, WS_YAB = 182 * MiB, WS_YC = 202 * MiB, WS_LSE = 238 * MiB;
constexpr size_t WS_BQN = 240 * MiB, WS_BKVN = 248 * MiB, WS_HID = 82 * MiB, WS_END = 252 * MiB;
constexpr size_t WS_SSQ = 3 * MiB + 512 * 1024, WS_BIAS2 = WS_SSQ + 131072;
constexpr size_t WS_SSQ1 = WS_BIAS2 + 131072, WS_BIAS1 = WS_SSQ1 + 131072;
constexpr size_t WS_H2 = 210 * MiB;
constexpr int LDS_BYTES = 147456;

__device__ const double INV64[32] = {1.0, 0.7498942093324559, 0.5623413251903491, 0.4216965034285822, 0.31622776601683794, 0.23713737056616552, 0.1778279410038923, 0.1333521432163324, 0.1, 0.07498942093324558, 0.05623413251903491, 0.042169650342858224, 0.03162277660168379, 0.023713737056616554, 0.01778279410038923, 0.01333521432163324, 0.01, 0.007498942093324558, 0.005623413251903491, 0.004216965034285823, 0.0031622776601683794, 0.0023713737056616554, 0.0017782794100389228, 0.001333521432163324, 0.001, 0.0007498942093324559, 0.0005623413251903491, 0.00042169650342858224, 0.00031622776601683794, 0.00023713737056616554, 0.00017782794100389227, 0.0001333521432163324};

DI float bf2f(bf16_t v) { return __uint_as_float((unsigned)v << 16); }
DI unsigned f2bf(float f) { unsigned u = __float_as_uint(f); return (u + 0x7fffu + ((u >> 16) & 1u)) >> 16; }
DI unsigned pk2(float lo, float hi) { return f2bf(lo) | (f2bf(hi) << 16); }
DI float wave_sum(float v) {
#pragma unroll
    for (int o = 1; o < 64; o <<= 1) v += __shfl_xor(v, o);
    return v;
}
DI float2 cs_of(double a) {
    const double rv = a * 0.15915494309189535; const double fr = rv - rint(rv); const float f = (float)fr;
    return make_float2(__builtin_amdgcn_cosf(f), __builtin_amdgcn_sinf(f));
}

struct Params { const float* in[18]; float* out; unsigned char* ws; };
typedef const __attribute__((address_space(4))) Params* KParams;
DI KParams kparams() { KParams k = (KParams)__builtin_amdgcn_kernarg_segment_ptr(); asm volatile("" : "+s"(k)); return k; }
#define PIN(i) (kparams()->in[i])
#define POUT (kparams()->out)
#define PWS (kparams()->ws)

DI void transpose_item(const float* W, int K, int N, bf16_t* WT, LAS float* scr, int item, int lane) {
    const int nblk = N / 32, kb = item / nblk, nb = item % nblk, k0 = 64 * kb, n0 = 32 * nb;
#pragma unroll 8
    for (int i = 0; i < 32; ++i) { const int kk = 2 * i + (lane >> 5); scr[kk * 33 + (lane & 31)] = W[(size_t)(k0 + kk) * N + n0 + (lane & 31)]; }
    asm volatile("s_waitcnt lgkmcnt(0)" ::: "memory");
    const int c = lane & 7;
#pragma unroll
    for (int j = 0; j < 4; ++j) { const int n = (lane >> 3) + 8 * j; const LAS float* s = scr + (8 * c) * 33 + n;
        u32x4 o; o.x = pk2(s[0 * 33], s[1 * 33]); o.y = pk2(s[2 * 33], s[3 * 33]); o.z = pk2(s[4 * 33], s[5 * 33]); o.w = pk2(s[6 * 33], s[7 * 33]);
        *(u32x4*)(WT + (size_t)(n0 + n) * K + k0 + 8 * c) = o; }
    asm volatile("s_waitcnt lgkmcnt(0)" ::: "memory");
}

DI void phase_prologue(unsigned char* lds, int bid, int G, int tid, int lane, int wave) {
    unsigned char* ws = PWS;
    {
        float* sil = (float*)lds;
        float* red = (float*)(lds + 16384);
        for (int i = tid; i < 4096; i += 512) { const float c = PIN(1)[i]; sil[i] = c / (1.f + __expf(-c)); }
        __syncthreads();
        float* mod = (float*)(ws + WS_MOD);
        for (int item = bid; item < 192; item += G) {
            const int l = item / 96, cgp = item % 96, col = cgp * 64 + lane;
            const float* W = PIN(2) + (size_t)l * 1024 * NMOD + col;
            float a0 = 0.f, a1 = 0.f, a2 = 0.f, a3 = 0.f;
            const int k0 = wave * 128;
#pragma unroll 8
            for (int k = k0; k < k0 + 128; ++k) { const float w = W[(size_t)k * NMOD]; a0 += sil[k] * w; a1 += sil[1024 + k] * w; a2 += sil[2048 + k] * w; a3 += sil[3072 + k] * w; }
            red[(wave * 4 + 0) * 64 + lane] = a0; red[(wave * 4 + 1) * 64 + lane] = a1; red[(wave * 4 + 2) * 64 + lane] = a2; red[(wave * 4 + 3) * 64 + lane] = a3;
            __syncthreads();
            if (wave < 4) { float s = 0.f;
#pragma unroll
                for (int w8 = 0; w8 < 8; ++w8) s += red[(w8 * 4 + wave) * 64 + lane];
                mod[(size_t)(l * 4 + wave) * NMOD + col] = s + PIN(3)[l * NMOD + col]; }
            __syncthreads();
        }
    }
    {
        LAS float* scr = (LAS float*)((LAS unsigned char*)lds + 32768 + wave * 8448);
        const int gw = bid * 8 + wave, NGW = G * 8;
        constexpr int I_IN = 16 * 69, I_OUT = 16 * 32, I_F1 = 16 * 128, I_F2 = 64 * 32, I_UQ = 4 * 12, I_UKV = 2 * 16;
        constexpr int I_L = I_IN + I_OUT + I_F1 + I_F2 + I_UQ + I_UKV;
        for (int it = gw; it < 2 * I_L; it += NGW) {
            const int l = it / I_L; int r = it % I_L;
            if (r < I_IN) { transpose_item(PIN(6) + (size_t)l * 1024 * 2208, 1024, 2208, (bf16_t*)(ws + WS_WIN) + (size_t)l * NPROJ * 1024, scr, r, lane); continue; } r -= I_IN;
            if (r < I_OUT) { transpose_item(PIN(14) + (size_t)l * 1024 * 1024, 1024, 1024, (bf16_t*)(ws + WS_WOUT) + (size_t)l * 1024 * 1024, scr, r, lane); continue; } r -= I_OUT;
            if (r < I_F1) { transpose_item(PIN(15) + (size_t)l * 1024 * 4096, 1024, 4096, (bf16_t*)(ws + WS_WFF1) + (size_t)l * 4096 * 1024, scr, r, lane); continue; } r -= I_F1;
            if (r < I_F2) { transpose_item(PIN(16) + (size_t)l * 4096 * 1024, 4096, 1024, (bf16_t*)(ws + WS_WFF2) + (size_t)l * 1024 * 4096, scr, r, lane); continue; } r -= I_F2;
            if (r < I_UQ) { transpose_item(PIN(11) + (size_t)l * 256 * 384, 256, 384, (bf16_t*)(ws + WS_WUQ) + (size_t)l * 512 * 256, scr, r, lane); continue; } r -= I_UQ;
            transpose_item(PIN(12) + (size_t)l * 128 * 512, 128, 512, (bf16_t*)(ws + WS_WUKV) + (size_t)l * 512 * 128, scr, r, lane);
        }
        const int gt = bid * 512 + tid, NT = G * 512;
        const u32x4 z = {0u, 0u, 0u, 0u};
        for (int i = gt; i < 2 * 96 * 128; i += NT) { const int l = i / (96 * 128), r = i % (96 * 128); *(u32x4*)((bf16_t*)(ws + WS_WIN) + (size_t)l * NPROJ * 1024 + (size_t)2208 * 1024 + (size_t)r * 8) = z; }
        for (int i = gt; i < 2 * 128 * 32; i += NT) { const int l = i / (128 * 32), r = i % (128 * 32); *(u32x4*)((bf16_t*)(ws + WS_WUQ) + (size_t)l * 512 * 256 + (size_t)384 * 256 + (size_t)r * 8) = z; }
        { float* ssq = (float*)(ws + WS_SSQ); for (int i = gt; i < 2 * T_TOK; i += NT) ssq[i] = 0.f; }
        { float* ssq = (float*)(ws + WS_SSQ1); for (int i = gt; i < 2 * T_TOK; i += NT) ssq[i] = 0.f; }
        float2* csax = (float2*)(ws + WS_CSAX); float2* csdil = (float2*)(ws + WS_CSDIL); float2* csmla = (float2*)(ws + WS_CSMLA);
        for (int i = gt; i < SEQ * 32; i += NT) {
            const int t = i >> 5, e = i & 31;
            csdil[i] = cs_of((double)t * INV64[e]);
            const int pos = (e < 16) ? (t >> 6) : (t & 63);
            csax[i] = cs_of((double)pos * INV64[2 * (e & 15)]);
            if (e < 16) csmla[t * 16 + e] = cs_of((double)t * INV64[2 * e]);
        }
    }
}

DI void vecmat4(const float* vec, int vstride, const float* W, int N, int nitems, float* out, int ostride, unsigned char* lds, int bid, int G, int tid, int lane, int wave) {
    float* sv = (float*)lds; float* red = (float*)(lds + 16384);
    for (int i = tid; i < 4096; i += 512) sv[i] = vec[(size_t)(i >> 10) * vstride + (i & 1023)];
    __syncthreads();
    for (int item = bid; item < nitems; item += G) {
        const int col = item * 64 + lane; const bool cin = (col < N);
        const float* Wc = W + (cin ? col : 0);
        float a0 = 0.f, a1 = 0.f, a2 = 0.f, a3 = 0.f;
        const int k0 = wave * 128;
#pragma unroll 8
        for (int k = k0; k < k0 + 128; ++k) { const float w = cin ? Wc[(size_t)k * N] : 0.f; a0 += sv[k] * w; a1 += sv[1024 + k] * w; a2 += sv[2048 + k] * w; a3 += sv[3072 + k] * w; }
        red[(wave * 4 + 0) * 64 + lane] = a0; red[(wave * 4 + 1) * 64 + lane] = a1; red[(wave * 4 + 2) * 64 + lane] = a2; red[(wave * 4 + 3) * 64 + lane] = a3;
        __syncthreads();
        if (wave < 4) { float t = 0.f;
#pragma unroll
            for (int w8 = 0; w8 < 8; ++w8) t += red[(w8 * 4 + wave) * 64 + lane];
            out[(size_t)wave * ostride + col] = t; }
        __syncthreads();
    }
}
DI void phase_norm_mod(const float* xin, const float* nw, const float* modl, int sh_off, int sc_off, bf16_t* H, int gw, int NGW, int lane) {
    for (int row = gw; row < T_TOK; row += NGW) {
        const f32x4* xr = (const f32x4*)(xin + (size_t)row * DM) + lane;
        f32x4 v[4]; float ss = 0.f;
#pragma unroll
        for (int j = 0; j < 4; ++j) { v[j] = xr[64 * j]; ss += (v[j].x * v[j].x + v[j].y * v[j].y) + (v[j].z * v[j].z + v[j].w * v[j].w); }
        const float rs = 1.0f / sqrtf(wave_sum(ss) * (1.f / DM) + EPS);
        const float* mb = modl + (size_t)(row >> 12) * NMOD;
        unsigned long long* o8 = (unsigned long long*)(H + (size_t)row * DM) + lane;
#pragma unroll
        for (int j = 0; j < 4; ++j) { const int col = 4 * (64 * j + lane);
            const f32x4 w = *(const f32x4*)(nw + col), s1 = *(const f32x4*)(mb + sc_off + col), s0 = *(const f32x4*)(mb + sh_off + col);
            const f32x4 y = (v[j] * rs * w) * (s1 + 1.0f) + s0;
            o8[64 * j] = (unsigned long long)pk2(y.x, y.y) | ((unsigned long long)pk2(y.z, y.w) << 32); }
    }
}
DI void phase_prenorm(const float* xin, const float* nw, const float* modl, int sc_off, bf16_t* H, float* ssq, int gw, int NGW, int lane) {
    for (int row = gw; row < T_TOK; row += NGW) {
        const f32x4* xr = (const f32x4*)(xin + (size_t)row * DM) + lane;
        f32x4 v[4]; float ss = 0.f;
#pragma unroll
        for (int j = 0; j < 4; ++j) { v[j] = xr[64 * j]; ss += (v[j].x * v[j].x + v[j].y * v[j].y) + (v[j].z * v[j].z + v[j].w * v[j].w); }
        ss = wave_sum(ss);
        if (lane == 0) ssq[row] = ss;
        const float* mb = modl + (size_t)(row >> 12) * NMOD;
        unsigned long long* o8 = (unsigned long long*)(H + (size_t)row * DM) + lane;
#pragma unroll
        for (int j = 0; j < 4; ++j) { const int col = 4 * (64 * j + lane);
            const f32x4 w = *(const f32x4*)(nw + col), s1 = *(const f32x4*)(mb + sc_off + col);
            const f32x4 y = (v[j] * w) * (s1 + 1.0f);
            o8[64 * j] = (unsigned long long)pk2(y.x, y.y) | ((unsigned long long)pk2(y.z, y.w) << 32); }
    }
}
DI void phase_final_norm(float* xio, const float* nw, int gw, int NGW, int lane) {
    for (int row = gw; row < T_TOK; row += NGW) {
        f32x4* xr = (f32x4*)(xio + (size_t)row * DM) + lane;
        f32x4 v[4]; float ss = 0.f;
#pragma unroll
        for (int j = 0; j < 4; ++j) { v[j] = xr[64 * j]; ss += (v[j].x * v[j].x + v[j].y * v[j].y) + (v[j].z * v[j].z + v[j].w * v[j].w); }
        const float rs = 1.0f / sqrtf(wave_sum(ss) * (1.f / DM) + EPS);
#pragma unroll
        for (int j = 0; j < 4; ++j) { const f32x4 w = *(const f32x4*)(nw + 4 * (64 * j + lane)); xr[64 * j] = v[j] * rs * w; }
    }
}
typedef short bfx8 __attribute__((ext_vector_type(8)));
DI void ld8f(const bf16_t* p, float (&x)[8]) { const bfx8 v = *(const bfx8*)p;
#pragma unroll
    for (int e = 0; e < 8; ++e) x[e] = bf2f((bf16_t)v[e]); }
DI void st8f(bf16_t* p, const float (&x)[8]) { u32x4 w; w.x = pk2(x[0], x[1]); w.y = pk2(x[2], x[3]); w.z = pk2(x[4], x[5]); w.w = pk2(x[6], x[7]); *(u32x4*)p = w; }
DI void ldcs8(const float2* t, float (&c)[8], float (&s)[8]) {
#pragma unroll
    for (int q = 0; q < 4; ++q) { const f32x4 v = *((const f32x4*)t + q); c[2 * q] = v.x; s[2 * q] = v.y; c[2 * q + 1] = v.z; s[2 * q + 1] = v.w; } }
template <int XM> DI void rope8(float (&x)[8], const float (&c)[8], const float (&s)[8], bool lo) {
#pragma unroll
    for (int e = 0; e < 8; ++e) { const float pr = __shfl_xor(x[e], XM); x[e] = lo ? (x[e] * c[e] - pr * s[e]) : (pr * s[e] + x[e] * c[e]); } }
DI void phase_post(int l, int gw, int NGW, int lane) {
    unsigned char* ws = PWS;
    bf16_t* proj = (bf16_t*)(ws + WS_PROJ); bf16_t* bqn = (bf16_t*)(ws + WS_BQN); bf16_t* bkvn = (bf16_t*)(ws + WS_BKVN);
    const float2* csax = (const float2*)(ws + WS_CSAX); const float2* csdil = (const float2*)(ws + WS_CSDIL); const float2* csmla = (const float2*)(ws + WS_CSMLA);
    const int j8 = lane & 7;
    float g1[8], g4[8];
    { const float* gp = (lane < 48) ? (PIN(7) + l * 64 + 8 * j8) : (PIN(8) + l * 64 + 8 * j8);
      const float* g4p = (lane < 32) ? (PIN(9) + l * 256 + 8 * lane) : (PIN(10) + l * 128 + 8 * (lane & 15));
#pragma unroll
      for (int e = 0; e < 8; ++e) { g1[e] = gp[e]; g4[e] = g4p[e]; } }
    const float sc1 = (lane < 48) ? QSCALE64 : 1.0f;
    const bool lo = (j8 < 4);
    for (int row = gw; row < T_TOK; row += NGW) {
        const int t = row & (SEQ - 1);
        bf16_t* pr = proj + (size_t)row * NPROJ;
        float x1[8], x2[8], x3[8], x4[8], c[8], s[8];
        ld8f(pr + 8 * lane, x1);
        if (lane < 48) { ld8f(pr + C_CQ + 8 * lane, x2); ld8f(pr + C_CK + 8 * lane, x3); }
        else {
#pragma unroll
            for (int e = 0; e < 8; ++e) { x2[e] = 0.f; x3[e] = 0.f; } }
        const bf16_t* p4 = (lane < 32) ? (pr + C_BQ + 8 * lane) : (lane < 48) ? (pr + C_BKV + 8 * (lane - 32)) : (pr + C_BKR + 8 * (lane & 3));
        ld8f(p4, x4);
        { float ss = 0.f;
#pragma unroll
          for (int e = 0; e < 8; ++e) ss += x1[e] * x1[e];
          ss += __shfl_xor(ss, 1); ss += __shfl_xor(ss, 2); ss += __shfl_xor(ss, 4);
          const float rs = 1.0f / sqrtf(ss * (1.f / 64.f) + EPS);
#pragma unroll
          for (int e = 0; e < 8; ++e) x1[e] = x1[e] * rs * g1[e];
          ldcs8(csax + t * 32 + 8 * (j8 & 3), c, s);
          rope8<4>(x1, c, s, lo);
#pragma unroll
          for (int e = 0; e < 8; ++e) x1[e] *= sc1;
          st8f(pr + 8 * lane, x1); }
        { ldcs8(csdil + t * 32 + 8 * (j8 & 3), c, s);
          rope8<4>(x2, c, s, lo); rope8<4>(x3, c, s, lo);
#pragma unroll
          for (int e = 0; e < 8; ++e) x2[e] *= QSCALE64;
          if (lane < 48) { st8f(pr + C_CQ + 8 * lane, x2); st8f(pr + C_CK + 8 * lane, x3); } }
        { float ss = 0.f;
          if (lane < 48) {
#pragma unroll
              for (int e = 0; e < 8; ++e) ss += x4[e] * x4[e]; }
          ss += __shfl_xor(ss, 1); ss += __shfl_xor(ss, 2); ss += __shfl_xor(ss, 4); ss += __shfl_xor(ss, 8); ss += __shfl_xor(ss, 16);
          const float rs = 1.0f / sqrtf(ss * ((lane < 32) ? (1.f / 256.f) : (1.f / 128.f)) + EPS);
          float y[8];
#pragma unroll
          for (int e = 0; e < 8; ++e) y[e] = x4[e] * rs * g4[e];
          ldcs8(csmla + t * 16 + 8 * (lane & 1), c, s);
          rope8<2>(x4, c, s, (lane & 2) == 0);
          if (lane < 32) st8f(bqn + (size_t)row * 256 + 8 * lane, y);
          else if (lane < 48) st8f(bkvn + (size_t)row * 128 + 8 * (lane - 32), y);
          else if (lane < 52) st8f(pr + C_BKR + 8 * (lane & 3), x4); }
    }
}
DI void phase_merge(int l, int gw, int NGW, int lane) {
    unsigned char* ws = PWS;
    const bf16_t* yab = (const bf16_t*)(ws + WS_YAB); const bf16_t* yc = (const bf16_t*)(ws + WS_YC); const float* lse = (const float*)(ws + WS_LSE);
    bf16_t* H = (bf16_t*)(ws + WS_H);
    const float* gain = PIN(13) + l * 1024;
    const bool inA = (lane < 48), inB = (lane < 32);
    float gA[8], gB[8], gC[8];
#pragma unroll
    for (int e = 0; e < 8; ++e) { gA[e] = inA ? gain[8 * lane + e] : 0.f; gB[e] = inB ? gain[384 + 8 * lane + e] : 0.f; gC[e] = inA ? gain[640 + 8 * lane + e] : 0.f; }
    const int h = (lane >> 3) < 6 ? (lane >> 3) : 0;
    for (int row = gw; row < T_TOK; row += NGW) {
        bf16_t* hr = H + (size_t)row * DM;
        float a[8], b[8], x[8];
#pragma unroll
        for (int e = 0; e < 8; ++e) { a[e] = 0.f; b[e] = 0.f; x[e] = 0.f; }
        if (inA) ld8f(yab + (size_t)row * 640 + 8 * lane, a);
        if (inB) ld8f(yab + (size_t)row * 640 + 384 + 8 * lane, b);
        if (inA) {
            float c0[8], c1[8], c2[8];
            ld8f(yc + (size_t)row * 384 + 8 * lane, c0); ld8f(yc + (size_t)(T_TOK + row) * 384 + 8 * lane, c1); ld8f(yc + (size_t)(2 * T_TOK + row) * 384 + 8 * lane, c2);
            const float l0 = lse[(size_t)row * 6 + h], l1 = lse[(size_t)(T_TOK + row) * 6 + h], l2 = lse[(size_t)(2 * T_TOK + row) * 6 + h];
            const float mx = fmaxf(l0, fmaxf(l1, l2));
            const float w0 = __builtin_amdgcn_exp2f(l0 - mx), w1 = __builtin_amdgcn_exp2f(l1 - mx), w2 = __builtin_amdgcn_exp2f(l2 - mx);
            const float inv = 1.0f / (w0 + w1 + w2);
#pragma unroll
            for (int e = 0; e < 8; ++e) x[e] = (w0 * c0[e] + w1 * c1[e] + w2 * c2[e]) * inv;
        }
        float sa = 0.f, sb = 0.f, sc = 0.f;
#pragma unroll
        for (int e = 0; e < 8; ++e) { sa += a[e] * a[e]; sb += b[e] * b[e]; sc += x[e] * x[e]; }
        const float ra = 1.0f / sqrtf(wave_sum(sa) * (1.f / 384.f) + EPS), rb = 1.0f / sqrtf(wave_sum(sb) * (1.f / 256.f) + EPS), rc = 1.0f / sqrtf(wave_sum(sc) * (1.f / 384.f) + EPS);
#pragma unroll
        for (int e = 0; e < 8; ++e) { a[e] *= ra * gA[e]; b[e] *= rb * gB[e]; x[e] *= rc * gC[e]; }
        if (inA) { st8f(hr + 8 * lane, a); st8f(hr + 640 + 8 * lane, x); }
        if (inB) st8f(hr + 384 + 8 * lane, b);
    }
}

namespace att {
typedef short bf16x8 __attribute__((ext_vector_type(8)));
typedef short s16x4 __attribute__((ext_vector_type(4)));
typedef float f32x16 __attribute__((ext_vector_type(16)));
#define SBAR() __builtin_amdgcn_sched_barrier(0)
constexpr int KBUF = 13312, VBUF = 8192, OFF_V = 4 * KBUF, OFF_WS = OFF_V + 4 * VBUF, OFF_Q = OFF_WS + 8 * 256;
constexpr float THR2 = 11.5f;
DI int crow(int r, int hi) { return (r & 3) + 8 * (r >> 2) + 4 * hi; }
DI unsigned cvtpk(float lo, float hi) { unsigned r; asm volatile("v_cvt_pk_bf16_f32 %0, %1, %2" : "=v"(r) : "v"(lo), "v"(hi)); return r; }
DI int v_st(int k, int c) { return ((k >> 3) * 2 + (c >> 5)) * 512 + ((k & 7) * 32 + (c & 31)) * 2; }
DI int v_rd_base(int lane) { return ((lane & 3) << 3) | (((lane >> 2) & 3) << 6) | (((lane >> 4) & 1) << 5) | (((lane >> 5) & 1) << 8); }
template <int OFF> DI s16x4 tr_read(int vb) { s16x4 r; asm volatile("ds_read_b64_tr_b16 %0, %1 offset:%2" : "=&v"(r) : "v"(vb), "i"(OFF) : "memory"); return r; }
template <int D0> DI void pv_one(f32x16& od, int vb, bf16x8 pa0, bf16x8 pa1, bf16x8 pa2, bf16x8 pa3) {
    const s16x4 l0 = tr_read<D0 * 512 + 0>(vb), h0 = tr_read<D0 * 512 + 1024>(vb), l1 = tr_read<D0 * 512 + 2048>(vb), h1 = tr_read<D0 * 512 + 3072>(vb);
    const s16x4 l2 = tr_read<D0 * 512 + 4096>(vb), h2 = tr_read<D0 * 512 + 5120>(vb), l3 = tr_read<D0 * 512 + 6144>(vb), h3 = tr_read<D0 * 512 + 7168>(vb);
    asm volatile("s_waitcnt lgkmcnt(0)" ::: "memory"); SBAR();
#define PK(L, H) (bf16x8){L[0], L[1], L[2], L[3], H[0], H[1], H[2], H[3]}
    od = __builtin_amdgcn_mfma_f32_32x32x16_bf16(pa0, PK(l0, h0), od, 0, 0, 0);
    od = __builtin_amdgcn_mfma_f32_32x32x16_bf16(pa1, PK(l1, h1), od, 0, 0, 0);
    od = __builtin_amdgcn_mfma_f32_32x32x16_bf16(pa2, PK(l2, h2), od, 0, 0, 0);
    od = __builtin_amdgcn_mfma_f32_32x32x16_bf16(pa3, PK(l3, h3), od, 0, 0, 0);
#undef PK
}
struct Desc {
    const bf16_t* q; long ldq;
    const bf16_t* k; long ldk;
    const bf16_t* k2; long ldk2;
    const bf16_t* v; long ldv;
    bf16_t* o; long ldo;
    float* lse; long ldlse;
    const float2* qcs;
    int kt0, kt1, q0;
    unsigned* counter;
};

template <int DQ, bool BAND>
DI int attn_unit(const Desc& u, unsigned char* lds, int tid, int wid, int lane) {
    constexpr int NK = DQ / 16, KROW = DQ * 2 + 16;
    const int r32 = lane & 31, hi = lane >> 5;
    char* K_lds = (char*)lds; char* V_lds = (char*)lds + OFF_V;
    float* wsf = (float*)(lds + OFF_WS) + wid * 64; float* li_l = wsf; float* al_l = wsf + 32;
    const int skey = tid >> 3, sc = tid & 7;
    int k1key = 0, k1c = 0; const bool k1on = (DQ == 96) && (tid < 256);
    int k0key = skey, k0c = sc;
    if constexpr (DQ == 96) { k0key = tid / 12; k0c = tid % 12; const int i1 = tid + 512; k1key = i1 / 12; k1c = i1 % 12; }
    const int vdst = v_st(skey, sc * 8);
    const int vb0 = (int)(unsigned)(size_t)V_lds + v_rd_base(lane);
    bf16x8 kreg0A, kreg1A, vregA, kreg0B, kreg1B, vregB;
    const bool k0two = (DQ == 96) && (k0c >= 8), k1two = (DQ == 96) && (k1c >= 8);
    const bf16_t* kp0 = k0two ? u.k2 + (long)k0key * u.ldk2 + (k0c - 8) * 8 : u.k + (long)k0key * u.ldk + k0c * 8;
    const bf16_t* kp1 = k1two ? u.k2 + (long)k1key * u.ldk2 + (k1c - 8) * 8 : u.k + (long)k1key * u.ldk + k1c * 8;
    const long ks0 = 64 * (k0two ? u.ldk2 : u.ldk), ks1 = 64 * (k1two ? u.ldk2 : u.ldk);
    const bf16_t* vp = u.v + (long)skey * u.ldv + sc * 8; const long vs = 64 * u.ldv;
#define A_LOAD(S, kt) do { const long kt_ = (long)(kt); kreg0##S = *(const bf16x8*)(kp0 + kt_ * ks0); \
        if constexpr (DQ == 96) { if (k1on) kreg1##S = *(const bf16x8*)(kp1 + kt_ * ks1); } \
        vreg##S = *(const bf16x8*)(vp + kt_ * vs); } while (0)
#define A_WRITE(S, b) do { *(bf16x8*)(K_lds + (b) * KBUF + k0key * KROW + k0c * 16) = kreg0##S; \
        if constexpr (DQ == 96) { if (k1on) *(bf16x8*)(K_lds + (b) * KBUF + k1key * KROW + k1c * 16) = kreg1##S; } \
        *(bf16x8*)(V_lds + (b) * VBUF + vdst) = vreg##S; } while (0)
    float m_reg = 0.f, l_reg = 0.f;
    f32x16 o0, o1, negm;
#pragma unroll
    for (int r = 0; r < 16; ++r) { o0[r] = 0.f; o1[r] = 0.f; negm[r] = 0.f; }
    const int qrow = u.q0 + wid * 32 + r32;
    const int qmin = u.q0 + wid * 32;
    A_LOAD(A, u.kt0); if (u.kt0 + 1 < u.kt1) A_LOAD(B, u.kt0 + 1);
    bf16x8 qr[NK];
    { const bf16_t* Qw = u.q + (long)(wid * 32 + r32) * u.ldq + hi * 8;
#pragma unroll
      for (int d0 = 0; d0 < NK; ++d0) qr[d0] = *(const bf16x8*)(Qw + d0 * 16);
      if constexpr (DQ == 96) {
          const float2* cs = u.qcs + (long)(wid * 32 + r32) * 16 + hi * 8;
#pragma unroll
          for (int d0 = 0; d0 < 4; ++d0) { bf16x8 t = qr[d0];
#pragma unroll
              for (int j = 0; j < 8; ++j) t[j] = (short)f2bf(bf2f((bf16_t)t[j]) * QSCALE96);
              qr[d0] = t; }
          bf16x8 a = qr[4], b = qr[5];
#pragma unroll
          for (int j = 0; j < 8; ++j) { const float2 c = cs[j]; const float x1 = bf2f((bf16_t)a[j]), x2 = bf2f((bf16_t)b[j]);
              a[j] = (short)f2bf((x1 * c.x - x2 * c.y) * QSCALE96); b[j] = (short)f2bf((x1 * c.y + x2 * c.x) * QSCALE96); }
          qr[4] = a; qr[5] = b;
      } }
    A_WRITE(A, 0); if (u.kt0 + 1 < u.kt1) A_WRITE(B, 1);
    __syncthreads();
    int un_next = 0;
    if (tid == 0) un_next = (int)__hip_atomic_fetch_add(u.counter, 1u, __ATOMIC_RELAXED, __HIP_MEMORY_SCOPE_AGENT);
    int sb = 0;
    for (int kt0_ = u.kt0; kt0_ < u.kt1; kt0_ += 2) {
      const bool n1 = (kt0_ + 2 < u.kt1), n2 = (kt0_ + 3 < u.kt1);
      if (n1) A_LOAD(A, kt0_ + 2);
      if (n2) A_LOAD(B, kt0_ + 3);
#pragma unroll
      for (int sub = 0; sub < 2; ++sub) {
        const int kt = kt0_ + sub, buf = sb + sub;
        if (kt >= u.kt1) break;
        bool active = true;
        if constexpr (BAND) active = !((kt * 64 + 63 < qmin - 64) || (kt * 64 > qmin + 31 + 64));
        if (active) {
            f32x16 p0, p1;
            const char* Kb = K_lds + buf * KBUF;
#pragma unroll
            for (int d0 = 0; d0 < NK; ++d0) { const int cb = (d0 * 16 + hi * 8) * 2;
                const bf16x8 b0 = *(const bf16x8*)(Kb + r32 * KROW + cb);
                const bf16x8 b1 = *(const bf16x8*)(Kb + (32 + r32) * KROW + cb);
                if (d0 == 0) { p0 = __builtin_amdgcn_mfma_f32_32x32x16_bf16(b0, qr[0], negm, 0, 0, 0); p1 = __builtin_amdgcn_mfma_f32_32x32x16_bf16(b1, qr[0], negm, 0, 0, 0); }
                else { p0 = __builtin_amdgcn_mfma_f32_32x32x16_bf16(b0, qr[d0], p0, 0, 0, 0); p1 = __builtin_amdgcn_mfma_f32_32x32x16_bf16(b1, qr[d0], p1, 0, 0, 0); } }
            if constexpr (BAND) {
                const int kb = kt * 64 + 4 * hi - qrow;
#pragma unroll
                for (int r = 0; r < 16; ++r) { const int dk = kb + (r & 3) + 8 * (r >> 2);
                    if (dk < -64 || dk > 64) p0[r] = -INFINITY;
                    if (dk + 32 < -64 || dk + 32 > 64) p1[r] = -INFINITY; }
            }
            float pmax = p0[0];
#pragma unroll
            for (int r = 1; r < 16; ++r) pmax = fmaxf(pmax, p0[r]);
#pragma unroll
            for (int r = 0; r < 16; ++r) pmax = fmaxf(pmax, p1[r]);
            pmax = fmaxf(pmax, __shfl_xor(pmax, 32));
            float alpha = 1.f;
            const bool first = (kt == u.kt0);
            if (first || !__all(pmax <= THR2)) {
                const float d = first ? pmax : fmaxf(pmax, 0.f);
                alpha = first ? 1.f : __builtin_amdgcn_exp2f(-d); m_reg += d;
#pragma unroll
                for (int r = 0; r < 16; ++r) { p0[r] -= d; p1[r] -= d; negm[r] = -m_reg; }
            }
            float ps = 0.f;
#pragma unroll
            for (int r = 0; r < 16; ++r) { p0[r] = __builtin_amdgcn_exp2f(p0[r]); p1[r] = __builtin_amdgcn_exp2f(p1[r]); ps += p0[r] + p1[r]; }
            ps += __shfl_xor(ps, 32);
            l_reg = l_reg * alpha + ps;
            if (__any(alpha < 1.f)) {
                if (hi == 0) al_l[r32] = alpha;
                asm volatile("s_waitcnt lgkmcnt(0)" ::: "memory");
#pragma unroll
                for (int r = 0; r < 16; ++r) { const float a = al_l[crow(r, hi)]; o0[r] *= a; o1[r] *= a; }
            }
            bf16x8 pa0, pa1, pa2, pa3;
#define PK4(P, BASE, OUT) do { u32x4 w = {cvtpk(P[BASE + 0], P[BASE + 1]), cvtpk(P[BASE + 2], P[BASE + 3]), cvtpk(P[BASE + 4], P[BASE + 5]), cvtpk(P[BASE + 6], P[BASE + 7])}; \
    OUT = *reinterpret_cast<bf16x8*>(&w); } while (0)
            PK4(p0, 0, pa0); PK4(p0, 8, pa1); PK4(p1, 0, pa2); PK4(p1, 8, pa3);
#undef PK4
            const int vb = vb0 + buf * VBUF;
            pv_one<0>(o0, vb, pa0, pa1, pa2, pa3);
            pv_one<1>(o1, vb, pa0, pa1, pa2, pa3);
        }
      }
      if (n1) A_WRITE(A, sb ^ 2);
      if (n2) A_WRITE(B, (sb ^ 2) + 1);
      __syncthreads();
      sb ^= 2;
    }
#undef A_LOAD
#undef A_WRITE
    if (hi == 0) li_l[r32] = l_reg;
    asm volatile("s_waitcnt lgkmcnt(0)" ::: "memory");
    bf16_t* Ow = u.o + (long)(wid * 32) * u.ldo;
#pragma unroll
    for (int r = 0; r < 16; ++r) { const int orow = crow(r, hi); const float rl = 1.0f / li_l[orow];
        Ow[(long)orow * u.ldo + r32] = (bf16_t)f2bf(o0[r] * rl);
        Ow[(long)orow * u.ldo + 32 + r32] = (bf16_t)f2bf(o1[r] * rl); }
    if constexpr (BAND) { if (hi == 0) u.lse[(long)(wid * 32 + r32) * u.ldlse] = m_reg + __builtin_amdgcn_logf(l_reg); }
    asm volatile("s_waitcnt lgkmcnt(0)" ::: "memory");
    return un_next;
}

DI int attn_unit_band(const Desc& u, unsigned char* lds, int tid, int wid, int lane) {
    constexpr int DQ = 64, NK = 4, KROW = 144, KB = 9216, VB = 8192, OFFV = 6 * KB, OFFS = OFFV + 6 * VB;
    const int r32 = lane & 31, hi = lane >> 5;
    char* K_lds = (char*)lds; char* V_lds = (char*)lds + OFFV;
    float* wsf = (float*)(lds + OFFS) + wid * 64; float* li_l = wsf; float* al_l = wsf + 32;
    const int skey = tid >> 3, sc = tid & 7;
    const int vdst = v_st(skey, sc * 8);
    const int vb0 = (int)(unsigned)(size_t)V_lds + v_rd_base(lane);
    const int nt = u.kt1 - u.kt0;
    bf16x8 kr[6], vr[6];
#pragma unroll
    for (int i = 0; i < 6; ++i) if (i < nt) { const long kb_ = (long)(u.kt0 + i) * 64;
        kr[i] = *(const bf16x8*)(u.k + (kb_ + skey) * u.ldk + sc * 8); vr[i] = *(const bf16x8*)(u.v + (kb_ + skey) * u.ldv + sc * 8); }
    bf16x8 qr[NK];
    { const bf16_t* Qw = u.q + (long)(wid * 32 + r32) * u.ldq + hi * 8;
#pragma unroll
      for (int d0 = 0; d0 < NK; ++d0) qr[d0] = *(const bf16x8*)(Qw + d0 * 16); }
#pragma unroll
    for (int i = 0; i < 6; ++i) if (i < nt) { *(bf16x8*)(K_lds + i * KB + skey * KROW + sc * 16) = kr[i]; *(bf16x8*)(V_lds + i * VB + vdst) = vr[i]; }
    float m_reg = 0.f, l_reg = 0.f; bool started = false;
    f32x16 o0, o1, negm;
#pragma unroll
    for (int r = 0; r < 16; ++r) { o0[r] = 0.f; o1[r] = 0.f; negm[r] = 0.f; }
    const int qrow = u.q0 + wid * 32 + r32;
    const int qmin = u.q0 + wid * 32;
    __syncthreads();
    int un_next = 0;
    if (tid == 0) un_next = (int)__hip_atomic_fetch_add(u.counter, 1u, __ATOMIC_RELAXED, __HIP_MEMORY_SCOPE_AGENT);
    for (int kt = u.kt0; kt < u.kt1; ++kt) {
        const int buf = kt - u.kt0;
        bool active = true;
        active = !((kt * 64 + 63 < qmin - 64) || (kt * 64 > qmin + 31 + 64));
        if (active) {
            f32x16 p0, p1;
            const char* Kb = K_lds + buf * KB;
#pragma unroll
            for (int d0 = 0; d0 < NK; ++d0) { const int cb = (d0 * 16 + hi * 8) * 2;
                const bf16x8 b0 = *(const bf16x8*)(Kb + r32 * KROW + cb);
                const bf16x8 b1 = *(const bf16x8*)(Kb + (32 + r32) * KROW + cb);
                if (d0 == 0) { p0 = __builtin_amdgcn_mfma_f32_32x32x16_bf16(b0, qr[0], negm, 0, 0, 0); p1 = __builtin_amdgcn_mfma_f32_32x32x16_bf16(b1, qr[0], negm, 0, 0, 0); }
                else { p0 = __builtin_amdgcn_mfma_f32_32x32x16_bf16(b0, qr[d0], p0, 0, 0, 0); p1 = __builtin_amdgcn_mfma_f32_32x32x16_bf16(b1, qr[d0], p1, 0, 0, 0); } }
            {
                const int kb = kt * 64 + 4 * hi - qrow;
#pragma unroll
                for (int r = 0; r < 16; ++r) { const int dk = kb + (r & 3) + 8 * (r >> 2);
                    if (dk < -64 || dk > 64) p0[r] = -INFINITY;
                    if (dk + 32 < -64 || dk + 32 > 64) p1[r] = -INFINITY; }
            }
            float pmax = p0[0];
#pragma unroll
            for (int r = 1; r < 16; ++r) pmax = fmaxf(pmax, p0[r]);
#pragma unroll
            for (int r = 0; r < 16; ++r) pmax = fmaxf(pmax, p1[r]);
            pmax = fmaxf(pmax, __shfl_xor(pmax, 32));
            float alpha = 1.f;
            const bool first = !started; started = true;
            if (first || !__all(pmax <= THR2)) {
                const float d = first ? pmax : fmaxf(pmax, 0.f);
                alpha = first ? 1.f : __builtin_amdgcn_exp2f(-d); m_reg += d;
#pragma unroll
                for (int r = 0; r < 16; ++r) { p0[r] -= d; p1[r] -= d; negm[r] = -m_reg; }
            }
            float ps = 0.f;
#pragma unroll
            for (int r = 0; r < 16; ++r) { p0[r] = __builtin_amdgcn_exp2f(p0[r]); p1[r] = __builtin_amdgcn_exp2f(p1[r]); ps += p0[r] + p1[r]; }
            ps += __shfl_xor(ps, 32);
            l_reg = l_reg * alpha + ps;
            if (__any(alpha < 1.f)) {
                if (hi == 0) al_l[r32] = alpha;
                asm volatile("s_waitcnt lgkmcnt(0)" ::: "memory");
#pragma unroll
                for (int r = 0; r < 16; ++r) { const float a = al_l[crow(r, hi)]; o0[r] *= a; o1[r] *= a; }
            }
            bf16x8 pa0, pa1, pa2, pa3;
#define PK4(P, BASE, OUT) do { u32x4 w = {cvtpk(P[BASE + 0], P[BASE + 1]), cvtpk(P[BASE + 2], P[BASE + 3]), cvtpk(P[BASE + 4], P[BASE + 5]), cvtpk(P[BASE + 6], P[BASE + 7])}; \
    OUT = *reinterpret_cast<bf16x8*>(&w); } while (0)
            PK4(p0, 0, pa0); PK4(p0, 8, pa1); PK4(p1, 0, pa2); PK4(p1, 8, pa3);
#undef PK4
            const int vb = vb0 + buf * VB;
            pv_one<0>(o0, vb, pa0, pa1, pa2, pa3);
            pv_one<1>(o1, vb, pa0, pa1, pa2, pa3);
        }
    }
    if (hi == 0) li_l[r32] = l_reg;
    asm volatile("s_waitcnt lgkmcnt(0)" ::: "memory");
    bf16_t* Ow = u.o + (long)(wid * 32) * u.ldo;
#pragma unroll
    for (int r = 0; r < 16; ++r) { const int orow = crow(r, hi); const float rl = 1.0f / li_l[orow];
        Ow[(long)orow * u.ldo + r32] = (bf16_t)f2bf(o0[r] * rl);
        Ow[(long)orow * u.ldo + 32 + r32] = (bf16_t)f2bf(o1[r] * rl); }
    { if (hi == 0) u.lse[(long)(wid * 32 + r32) * u.ldlse] = m_reg + __builtin_amdgcn_logf(l_reg); }
    asm volatile("s_waitcnt lgkmcnt(0)" ::: "memory");
    __syncthreads();
    return un_next;
}
}

constexpr int NU_B = 4 * 4 * 16, NU_A = 4 * 6 * 16, NU_C = 4 * 6 * 48, NU_ALL = NU_B + NU_A + NU_C;
DI void phase_attention(unsigned* counter, unsigned char* lds, int tid, int wid, int lane) {
    unsigned char* ws = PWS;
    const bf16_t* proj = (const bf16_t*)(ws + WS_PROJ); const bf16_t* qb = (const bf16_t*)(ws + WS_QB); const bf16_t* kvb = (const bf16_t*)(ws + WS_KVB);
    bf16_t* yab = (bf16_t*)(ws + WS_YAB); bf16_t* yc = (bf16_t*)(ws + WS_YC); float* lse = (float*)(ws + WS_LSE);
    volatile int* slot = (volatile int*)(lds + att::OFF_Q);
    if (tid == 0) *slot = (int)__hip_atomic_fetch_add(counter, 1u, __ATOMIC_RELAXED, __HIP_MEMORY_SCOPE_AGENT);
    __syncthreads();
    int un = __builtin_amdgcn_readfirstlane(*slot);
    __syncthreads();
    for (;;) {
        if (un >= NU_ALL) break;
        int un_next;
        int tid_u = tid; asm volatile("" : "+v"(tid_u)); const int lane_u = tid_u & 63;
        att::Desc d;
        d.k2 = nullptr; d.ldk2 = 0; d.lse = nullptr; d.ldlse = 0; d.qcs = nullptr; d.q0 = 0; d.counter = counter;
        if (un < NU_B) {
            const int b = un >> 6, h = (un >> 4) & 3, blk = un & 15; const long tok = (long)b * SEQ + blk * 256;
            d.q = qb + tok * 384 + h * 96; d.ldq = 384;
            d.k = kvb + (long)b * SEQ * 512 + h * 128; d.ldk = 512;
            d.k2 = proj + (long)b * SEQ * NPROJ + C_BKR; d.ldk2 = NPROJ;
            d.v = kvb + (long)b * SEQ * 512 + h * 128 + 64; d.ldv = 512;
            d.o = yab + tok * 640 + 384 + h * 64; d.ldo = 640;
            d.qcs = (const float2*)(ws + WS_CSMLA) + (long)(blk * 256) * 16;
            d.kt0 = 0; d.kt1 = SEQ / 64;
            un_next = att::attn_unit<96, false>(d, lds, tid_u, wid, lane_u);
        } else if (un < NU_B + NU_A) {
            const int v = un - NU_B; const int b = v / 96, h = (v / 16) % 6, blk = v & 15; const long tok = (long)b * SEQ + blk * 256;
            d.q = proj + tok * NPROJ + C_AQ + h * 64; d.ldq = NPROJ;
            d.k = proj + (long)b * SEQ * NPROJ + C_AK + (h / 3) * 64; d.ldk = NPROJ;
            d.v = proj + (long)b * SEQ * NPROJ + C_AV + (h / 3) * 64; d.ldv = NPROJ;
            d.o = yab + tok * 640 + h * 64; d.ldo = 640;
            d.kt0 = 0; d.kt1 = SEQ / 64;
            un_next = att::attn_unit<64, false>(d, lds, tid_u, wid, lane_u);
        } else {
            const int v = un - NU_B - NU_A; const int bh = v / 48, w = v % 48; const int b = bh / 6, h = bh % 6;
            int br, r, blk, dil;
            if (w < 16) { br = 0; r = 0; blk = w; dil = 1; } else if (w < 32) { br = 1; r = (w - 16) >> 2; blk = (w - 16) & 3; dil = 4; } else { br = 2; r = w - 32; blk = 0; dil = 16; }
            const int L = SEQ / dil; const long tok0 = (long)b * SEQ + r; const long tq = tok0 + (long)blk * 256 * dil;
            d.q = proj + tq * NPROJ + C_CQ + h * 64; d.ldq = (long)dil * NPROJ;
            d.k = proj + tok0 * NPROJ + C_CK + h * 64; d.ldk = (long)dil * NPROJ;
            d.v = proj + tok0 * NPROJ + C_CV + h * 64; d.ldv = (long)dil * NPROJ;
            d.o = yc + ((long)br * T_TOK + tq) * 384 + h * 64; d.ldo = (long)dil * 384;
            d.lse = lse + ((long)br * T_TOK + tq) * 6 + h; d.ldlse = (long)dil * 6;
            d.q0 = blk * 256;
            d.kt0 = (blk * 4 - 1 < 0) ? 0 : blk * 4 - 1; d.kt1 = (blk * 4 + 5 > L / 64) ? L / 64 : blk * 4 + 5;
            un_next = att::attn_unit_band(d, lds, tid_u, wid, lane_u);
        }
        if (tid == 0) *slot = un_next;
        __syncthreads();
        un = __builtin_amdgcn_readfirstlane(*slot);
        __syncthreads();
    }
}

#define XB_TMO      128
#define XB_XCNT(j)  (256  + 64 * (j))
#define XB_XSUB(j)  (1280 + 64 * (j))
#define XB_XGEN(j)  (2304 + 64 * (j))
#define XB_TOP      3328
#define XB_TOPGEN   3392
#define XCD_BAR_WORDS 3456
#define XB_SPIN_CAP (1u << 18)

__device__ __forceinline__ unsigned xb_ld(unsigned* p)              { return __hip_atomic_load(p, __ATOMIC_RELAXED, __HIP_MEMORY_SCOPE_AGENT); }
__device__ __forceinline__ unsigned xb_add(unsigned* p, unsigned v) { return __hip_atomic_fetch_add(p, v, __ATOMIC_RELAXED, __HIP_MEMORY_SCOPE_AGENT); }
__device__ __forceinline__ unsigned xb_xcc_id() { return (unsigned)__builtin_amdgcn_s_getreg((3 << 11) | 20) & 0xFu; }
#define XB_SPIN(cond, bar) do { unsigned _sp = 0; while (cond) { __builtin_amdgcn_s_sleep(1); \
    if ((++_sp & 255u) == 0u) { if (xb_ld(&(bar)[XB_TMO])) break; if (_sp > XB_SPIN_CAP) { atomicAdd(&(bar)[XB_TMO], 1u); break; } } } } while (0)

struct XcdBarrier {
    unsigned* bar; unsigned x;
    volatile LAS unsigned* st;
};

__device__ __forceinline__ XcdBarrier xcd_barrier_post(unsigned* bar, volatile LAS unsigned* st) {
    XcdBarrier b; b.bar = bar; b.x = xb_xcc_id(); b.st = st;
    if (threadIdx.x == 0) (void)xb_add(&bar[XB_XCNT(b.x)], 1u);
    return b;
}
__device__ __forceinline__ void xcd_barrier_complete(unsigned* bar, unsigned x, unsigned& nloc, unsigned& nx) {
    const unsigned G = gridDim.x * gridDim.y * gridDim.z;
    unsigned sum, cnt, mine, sp = 0u;
    for (;;) {
        sum = 0u; cnt = 0u; mine = 0u;
#pragma unroll
        for (unsigned j = 0; j < 16; ++j) { const unsigned c = xb_ld(&bar[XB_XCNT(j)]); sum += c; cnt += (c > 0u) ? 1u : 0u; mine = (j == x) ? c : mine; }
        if (sum == G) break;
        __builtin_amdgcn_s_sleep(1);
        if ((++sp & 255u) == 0u) { if (xb_ld(&bar[XB_TMO])) break; if (sp > XB_SPIN_CAP) { atomicAdd(&bar[XB_TMO], 1u); break; } }
    }
    nloc = mine > 0u ? mine : 1u; nx = cnt > 0u ? cnt : 1u;
}

__device__ __forceinline__ void xcd_barrier(const XcdBarrier& b) {
    asm volatile("s_waitcnt vmcnt(0)" ::: "memory");
    __syncthreads();
    if (threadIdx.x == 0) {
        unsigned* bar = b.bar;
        __builtin_amdgcn_s_waitcnt(0);
        unsigned nloc = b.st[0], nx = b.st[1];
        if (nloc == 0u) { xcd_barrier_complete(bar, b.x, nloc, nx); b.st[0] = nloc; b.st[1] = nx; }
        const unsigned old = xb_add(&bar[XB_XSUB(b.x)], 1u);
        const unsigned gen = old / nloc;
        if (old + 1u == (gen + 1u) * nloc) {
            __builtin_amdgcn_fence(__ATOMIC_RELEASE, "agent");
            asm volatile("s_waitcnt vmcnt(0)" ::: "memory");
            const unsigned og = xb_add(&bar[XB_TOP], 1u);
            const unsigned tg = og / nx;
            if (og + 1u == (tg + 1u) * nx) xb_add(&bar[XB_TOPGEN], 1u);
            else XB_SPIN(xb_ld(&bar[XB_TOPGEN]) == tg, bar);
            __builtin_amdgcn_fence(__ATOMIC_ACQUIRE, "agent");
            xb_add(&bar[XB_XGEN(b.x)], 1u);
            asm volatile("s_waitcnt vmcnt(0)" ::: "memory");
        } else {
            XB_SPIN(xb_ld(&bar[XB_XGEN(b.x)]) == gen, bar);
            __builtin_amdgcn_fence(__ATOMIC_ACQUIRE, "agent");
            asm volatile("s_waitcnt vmcnt(0)" ::: "memory");
        }
    }
    __syncthreads();
}

__global__ void __launch_bounds__(512, 2) mega_fwd(Params p) {
    extern __shared__ __attribute__((aligned(16))) unsigned char lds[];
    cg::grid_group grid = cg::this_grid();
    const int tid = threadIdx.x, lane = tid & 63, wave = __builtin_amdgcn_readfirstlane(tid >> 6);
    const int bid = blockIdx.x, G = gridDim.x;
    const int gw = bid * 8 + wave, NGW = G * 8;
    unsigned char* ws = PWS;
    PG8_LAS unsigned char* lds3 = (PG8_LAS unsigned char*)lds;
    bf16_t* H = (bf16_t*)(ws + WS_H);
    const float* mod = (const float*)(ws + WS_MOD);

    volatile LAS unsigned* bst = (volatile LAS unsigned*)((LAS unsigned char*)lds + 139264);
    if (tid < 2) bst[tid] = 0u;
    { const int gt0 = bid * 512 + tid; if (gt0 < 8192) ((unsigned*)(ws + WS_CTL))[gt0] = 0u; }
    __syncthreads();
    phase_prologue(lds, bid, G, tid, lane, wave);
    grid.sync();
    const XcdBarrier xbar = xcd_barrier_post((unsigned*)(ws + WS_CTL) + 1024, bst);
#define GRID_SYNC() xcd_barrier(xbar)

#define FRESH_IDS() int tid_f = threadIdx.x; asm volatile("" : "+v"(tid_f)); const int lane_f = tid_f & 63, wave_f = __builtin_amdgcn_readfirstlane(tid_f >> 6), gw_f = bid * 8 + wave_f; (void)lane_f; (void)gw_f
    for (int l = 0; l < 2; ++l) {
        const float* modl = mod + (size_t)l * 4 * NMOD;
        const float* xin = (l == 0) ? PIN(0) : POUT;
        if (l == 0) {
            FRESH_IDS(); phase_prenorm(xin, PIN(4), modl, 1024, H, (float*)(ws + WS_SSQ1), gw_f, NGW, lane_f);
#pragma unroll 1
            for (int ll = 0; ll < 2; ++ll) { const float* ml = mod + (size_t)ll * 4 * NMOD;
                vecmat4(ml, NMOD, PIN(6) + (size_t)ll * 1024 * 2208, 2208, 36, (float*)(ws + WS_BIAS1) + (size_t)ll * 4 * NPROJ, NPROJ, lds, (bid + G - (ll * 100) % G) % G, G, tid_f, lane_f, wave_f);
                vecmat4(ml + 3072, NMOD, PIN(15) + (size_t)ll * 1024 * DFF, DFF, DFF / 64, (float*)(ws + WS_BIAS2) + (size_t)ll * 4 * DFF, DFF, lds, (bid + G - (36 + ll * 100) % G) % G, G, tid_f, lane_f, wave_f); }
            GRID_SYNC();
        }
        { pg8::Gemm g{H, (const bf16_t*)(ws + WS_WIN) + (size_t)l * NPROJ * 1024, T_TOK, 2048, DM}; pg8::StaticOrder S; S.init(T_TOK, 2048, G, bid);
          pg8::EpiStoreRS<0> E{(bf16_t*)(ws + WS_PROJ), NPROJ, (const float*)(ws + WS_SSQ1) + (size_t)l * T_TOK, (const float*)(ws + WS_BIAS1) + (size_t)l * 4 * NPROJ, NPROJ};
          pg8::gemm_phase<pg8::EpiStoreRS<0>, pg8::StaticOrder, true, true>(lds3, g, S, E); }
        GRID_SYNC();
        { const int nbig = G / 4;
          if (bid < nbig) { pg8::Gemm g{H, (const bf16_t*)(ws + WS_WIN) + (size_t)l * NPROJ * 1024 + (size_t)2048 * 1024, T_TOK, 256, DM}; pg8::StaticOrder S; S.init(T_TOK, 256, nbig, bid);
              pg8::EpiStoreRS<0> E{(bf16_t*)(ws + WS_PROJ) + 2048, NPROJ, (const float*)(ws + WS_SSQ1) + (size_t)l * T_TOK, (const float*)(ws + WS_BIAS1) + (size_t)l * 4 * NPROJ + 2048, NPROJ};
              pg8::gemm_phase<pg8::EpiStoreRS<0>, pg8::StaticOrder, true, true>(lds3, g, S, E); }
          else { FRESH_IDS(); phase_post(l, (bid - nbig) * 8 + wave_f, (G - nbig) * 8, lane_f); } }
        GRID_SYNC();
        { const int half = G / 2;
          if (bid < half) { pg8::Gemm g{(const bf16_t*)(ws + WS_BQN), (const bf16_t*)(ws + WS_WUQ) + (size_t)l * 512 * 256, T_TOK, 512, 256}; pg8::StaticOrder S; S.init(T_TOK, 512, half, bid);
              pg8::EpiStore<0> E{(bf16_t*)(ws + WS_QB), 384, 384};
              pg8::gemm_phase<pg8::EpiStore<0>, pg8::StaticOrder, true, true>(lds3, g, S, E); }
          else { pg8::Gemm g{(const bf16_t*)(ws + WS_BKVN), (const bf16_t*)(ws + WS_WUKV) + (size_t)l * 512 * 128, T_TOK, 512, 128}; pg8::StaticOrder S; S.init(T_TOK, 512, G - half, bid - half);
              pg8::EpiStore<0> E{(bf16_t*)(ws + WS_KVB), 512, 512};
              pg8::gemm_phase<pg8::EpiStore<0>, pg8::StaticOrder, true, true>(lds3, g, S, E); } }
        GRID_SYNC();
        { FRESH_IDS(); phase_attention((unsigned*)(ws + WS_CTL) + 64 * l, lds, tid_f, wave_f, lane_f); }
        GRID_SYNC();
        { FRESH_IDS(); phase_merge(l, gw_f, NGW, lane_f); }
        GRID_SYNC();
        { pg8::Gemm g{H, (const bf16_t*)(ws + WS_WOUT) + (size_t)l * 1024 * 1024, T_TOK, DM, DM}; pg8::StaticOrder S; S.init(T_TOK, DM, G, bid);
          pg8::EpiResidH E{xin, POUT, modl + 2048, PIN(5) + l * DM, modl + 4096, (bf16_t*)(ws + WS_H2), (float*)(ws + WS_SSQ) + (size_t)l * T_TOK};
          pg8::gemm_phase<pg8::EpiResidH, pg8::StaticOrder, true, true>(lds3, g, S, E); }
        GRID_SYNC();
        { pg8::Gemm g{(const bf16_t*)(ws + WS_H2), (const bf16_t*)(ws + WS_WFF1) + (size_t)l * DFF * 1024, T_TOK, DFF, DM}; pg8::StaticOrder S; S.init(T_TOK, DFF, G, bid);
          pg8::EpiStoreRS<2> E{(bf16_t*)(ws + WS_HID), DFF, (const float*)(ws + WS_SSQ) + (size_t)l * T_TOK, (const float*)(ws + WS_BIAS2) + (size_t)l * 4 * DFF, DFF};
          pg8::gemm_phase<pg8::EpiStoreRS<2>, pg8::StaticOrder, true, true>(lds3, g, S, E); }
        GRID_SYNC();
        { pg8::Gemm g{(const bf16_t*)(ws + WS_HID), (const bf16_t*)(ws + WS_WFF2) + (size_t)l * 1024 * DFF, T_TOK, DM, DFF}; pg8::StaticOrder S; S.init(T_TOK, DM, G, bid);
          pg8::EpiResidH E{POUT, POUT, modl + 5120, PIN(4) + DM, mod + (size_t)4 * NMOD + 1024, (l == 0) ? H : (bf16_t*)nullptr, (float*)(ws + WS_SSQ1) + T_TOK};
          pg8::gemm_phase<pg8::EpiResidH, pg8::StaticOrder, true, true>(lds3, g, S, E); }
        GRID_SYNC();
    }
    { FRESH_IDS(); phase_final_norm(POUT, PIN(17), gw_f, NGW, lane_f); }
}

extern "C" void kernel_launch(void* const* d_in, const int* in_sizes, int n_in, void* d_out, int out_size, void* d_ws, size_t ws_size, hipStream_t stream) {
    static int grid_blocks = 0;
    if (grid_blocks == 0) {
        if (n_in != 18 || out_size != T_TOK * DM || ws_size < WS_END) { fprintf(stderr, "kernel_launch: unexpected shapes (n_in %d out %d ws %zu)\n", n_in, out_size, ws_size); grid_blocks = -1; return; }
        int dev = 0, cus = 0, per_cu = 0;
        (void)hipGetDevice(&dev);
        (void)hipDeviceGetAttribute(&cus, hipDeviceAttributeMultiprocessorCount, dev);
        if (hipFuncSetAttribute((const void*)mega_fwd, hipFuncAttributeMaxDynamicSharedMemorySize, LDS_BYTES) != hipSuccess) { fprintf(stderr, "kernel_launch: hipFuncSetAttribute failed\n"); grid_blocks = -1; return; }
        if (hipOccupancyMaxActiveBlocksPerMultiprocessor(&per_cu, (const void*)mega_fwd, 512, LDS_BYTES) != hipSuccess || per_cu < 1) { fprintf(stderr, "kernel_launch: the occupancy query reports %d resident workgroups per CU for this kernel (512 threads, %d B LDS); nothing launched\n", per_cu, LDS_BYTES); (void)hipGetLastError(); grid_blocks = -1; return; }
        grid_blocks = cus * 1;
        if (per_cu < 1) grid_blocks = -1;
    }
    if (grid_blocks < 0) return;
    Params p{};
    for (int i = 0; i < 18; ++i) p.in[i] = (const float*)d_in[i];
    p.out = (float*)d_out; p.ws = (unsigned char*)d_ws;
    void* args[] = {&p};
    hipError_t e = hipLaunchCooperativeKernel((const void*)mega_fwd, dim3(grid_blocks), dim3(512), args, LDS_BYTES, stream);
    if (e != hipSuccess) fprintf(stderr, "cooperative launch failed: %s (grid %d)\n", hipGetErrorString(e), grid_blocks);
}
```
